# Optimizing an MI355X kernel written in HIP

```python
import jax, jax.numpy as jnp
from jax import lax
import numpy as np

D_MODEL = 1024
BATCH = 8
SEQ = 4096
DEPTH = 1

CHUNK = 64
Q_BLOCK = 128
EPS = 1e-6

N_HEADS_A = 8
N_KV_A = 2
HEAD_DIM = 64
ROT_DIM = HEAD_DIM // 4
ROPE_THETA = 500000.0
N_IDX_HEADS = 8
IDX_DIM = 32
IDX_ROT_DIM = IDX_DIM // 4
TOPK_MAX = 256
WIDTH_A = N_HEADS_A * HEAD_DIM

POOL_WINDOWS = (2, 4, 8, 16)
N_POOL_GROUPS = 4
POOL_GROUP_DIM = 128
WIDTH_B = N_POOL_GROUPS * POOL_GROUP_DIM

N_BRANCHES = 2

SPLIT_SIZES = (
    WIDTH_A,
    N_KV_A * HEAD_DIM,
    N_KV_A * HEAD_DIM,
    N_IDX_HEADS * IDX_DIM,
    IDX_DIM,
    N_IDX_HEADS,
    WIDTH_A,
    WIDTH_B,
    WIDTH_B,
    N_BRANCHES * D_MODEL,
)
D_IN = int(sum(SPLIT_SIZES))
SPLIT_POINTS = [int(s) for s in np.cumsum(SPLIT_SIZES)[:-1]]

kernel_name = "hybrid_dsa_pool_gated_block"


def rms_norm(t, g):
    tf = t.astype(jnp.float32)
    tf = tf * lax.rsqrt(jnp.mean(tf * tf, axis=-1, keepdims=True) + EPS)
    return (tf * g.astype(jnp.float32)).astype(t.dtype)


def rope_tables(positions, rot_dim):
    half = rot_dim // 2
    inv_freq = ROPE_THETA ** (-jnp.arange(half, dtype=jnp.float32) / half)
    ang = positions.astype(jnp.float32)[..., None] * inv_freq
    return jnp.cos(ang), jnp.sin(ang)


def apply_partial_rope(t, cos, sin):
    half = cos.shape[-1]
    tf = t.astype(jnp.float32)
    c = cos[:, :, None, :]
    s = sin[:, :, None, :]
    t1 = tf[..., :half]
    t2 = tf[..., half:2 * half]
    out = jnp.concatenate([t1 * c - t2 * s, t1 * s + t2 * c, tf[..., 2 * half:]], axis=-1)
    return out.astype(t.dtype)


def dsa_attention(q, k, v, qi, ki, wi, k_sel):
    B, S = q.shape[0], q.shape[1]
    n_blocks = S // Q_BLOCK
    rep = N_HEADS_A // N_KV_A
    key_chunk = jnp.arange(S) // CHUNK
    scale = HEAD_DIM ** -0.5

    def block(i):
        start = i * Q_BLOCK
        qb = lax.dynamic_slice_in_dim(q, start, Q_BLOCK, axis=1)
        qib = lax.dynamic_slice_in_dim(qi, start, Q_BLOCK, axis=1)
        wib = lax.dynamic_slice_in_dim(wi, start, Q_BLOCK, axis=1)
        q_chunk = (start + jnp.arange(Q_BLOCK)) // CHUNK
        allowed = key_chunk[None, :] <= q_chunk[:, None]
        logits = jnp.einsum('bqhd,bsd->bqhs', qib, ki)
        iscore = jnp.einsum('bqhs,bqh->bqs', jax.nn.relu(logits), wib).astype(jnp.float32)
        iscore = jnp.where(allowed[None], iscore, -jnp.inf)
        _, idx = lax.top_k(iscore, k_sel)
        valid = key_chunk[idx] <= q_chunk[None, :, None]
        kg = jax.vmap(lambda kb, ib: kb[ib])(k, idx)
        vg = jax.vmap(lambda vb, ib: vb[ib])(v, idx)
        qg = qb.reshape(B, Q_BLOCK, N_KV_A, rep, HEAD_DIM)
        s = jnp.einsum('bqgrd,bqkgd->bqgrk', qg, kg).astype(jnp.float32) * scale
        s = jnp.where(valid[:, :, None, None, :], s, -jnp.inf)
        p = jax.nn.softmax(s, axis=-1).astype(v.dtype)
        o = jnp.einsum('bqgrk,bqkgd->bqgrd', p, vg)
        return o.reshape(B, Q_BLOCK, N_HEADS_A * HEAD_DIM)

    out = lax.map(block, jnp.arange(n_blocks))
    return out.transpose(1, 0, 2, 3).reshape(B, S, N_HEADS_A * HEAD_DIM)


def multiscale_pool(u, pool_w, pool_scale):
    B, S = u.shape[0], u.shape[1]
    ug = u.astype(jnp.float32).reshape(B, S, N_POOL_GROUPS, POOL_GROUP_DIM)
    cs = jnp.cumsum(ug, axis=1)
    t = jnp.arange(S)
    outs = []
    for g, w in enumerate(POOL_WINDOWS):
        c = cs[:, :, g]
        lagged = jnp.pad(c, ((0, 0), (w, 0), (0, 0)))[:, :S]
        count = jnp.minimum(t + 1, w).astype(jnp.float32)[None, :, None]
        outs.append((c - lagged) / count - ug[:, :, g])
    pooled = jnp.stack(outs, axis=2).astype(u.dtype)
    mixed = jnp.einsum('bsgc,gcd->bsgd', pooled, pool_w)
    return mixed.reshape(B, S, WIDTH_B) * pool_scale


def setup_inputs(seed: int = 0) -> dict:
    key = jax.random.key(seed)
    ks = jax.random.split(key, 13)
    f32 = jnp.float32
    x = jax.random.normal(ks[0], (BATCH, SEQ, D_MODEL), f32)
    offsets = jax.random.randint(ks[1], (BATCH, 1), 0, 100000, dtype=jnp.int32)
    positions = (jnp.arange(SEQ, dtype=jnp.int32)[None, :] + offsets).astype(jnp.int32)
    norm_g = 1.0 + 0.02 * jax.random.normal(ks[2], (DEPTH, D_MODEL), f32)
    w_in = jax.random.normal(ks[3], (DEPTH, D_MODEL, D_IN), f32) * D_MODEL ** -0.5
    merge_bias = 0.02 * jax.random.normal(ks[4], (DEPTH, N_BRANCHES, D_MODEL), f32)
    q_norm_g = 1.0 + 0.02 * jax.random.normal(ks[5], (DEPTH, HEAD_DIM), f32)
    k_norm_g = 1.0 + 0.02 * jax.random.normal(ks[6], (DEPTH, HEAD_DIM), f32)
    pool_w = jax.random.normal(ks[7], (DEPTH, N_POOL_GROUPS, POOL_GROUP_DIM, POOL_GROUP_DIM), f32) * POOL_GROUP_DIM ** -0.5
    pool_scale = 1.0 + 0.1 * jax.random.normal(ks[8], (DEPTH, WIDTH_B), f32)
    w_branch_a = jax.random.normal(ks[9], (DEPTH, WIDTH_A, D_MODEL), f32) * WIDTH_A ** -0.5
    w_branch_b = jax.random.normal(ks[10], (DEPTH, WIDTH_B, D_MODEL), f32) * WIDTH_B ** -0.5
    w_out = jax.random.normal(ks[11], (DEPTH, D_MODEL, D_MODEL), f32) * D_MODEL ** -0.5
    return {"x": x, "positions": positions, "norm_g": norm_g, "w_in": w_in,
            "merge_bias": merge_bias, "q_norm_g": q_norm_g, "k_norm_g": k_norm_g,
            "pool_w": pool_w, "pool_scale": pool_scale, "w_branch_a": w_branch_a,
            "w_branch_b": w_branch_b, "w_out": w_out}


def reference(x, positions, norm_g, w_in, merge_bias, q_norm_g, k_norm_g, pool_w, pool_scale,
              w_branch_a, w_branch_b, w_out):
    B, S = x.shape[0], x.shape[1]
    k_sel = min(TOPK_MAX, S // 4)
    cos_a, sin_a = rope_tables(positions, ROT_DIM)
    cos_i, sin_i = rope_tables(positions, IDX_ROT_DIM)
    for layer in range(DEPTH):
        h = rms_norm(x, norm_g[layer])
        proj = h @ w_in[layer]
        q, k, v, qi, ki, wi, z_a, u_b, z_b, gates = jnp.split(proj, SPLIT_POINTS, axis=-1)

        q = q.reshape(B, S, N_HEADS_A, HEAD_DIM)
        k = k.reshape(B, S, N_KV_A, HEAD_DIM)
        v = v.reshape(B, S, N_KV_A, HEAD_DIM)
        q = apply_partial_rope(rms_norm(q, q_norm_g[layer]), cos_a, sin_a)
        k = apply_partial_rope(rms_norm(k, k_norm_g[layer]), cos_a, sin_a)
        qi = apply_partial_rope(qi.reshape(B, S, N_IDX_HEADS, IDX_DIM), cos_i, sin_i) * (IDX_DIM ** -0.5)
        ki = apply_partial_rope(ki[:, :, None, :], cos_i, sin_i)[:, :, 0, :]
        wi = wi * (N_IDX_HEADS ** -0.5)
        a = dsa_attention(q, k, v, qi, ki, wi, k_sel) * jax.nn.silu(z_a)

        b = multiscale_pool(u_b, pool_w[layer], pool_scale[layer]) * jax.nn.silu(z_b)

        g = jax.nn.sigmoid(gates.reshape(B, S, N_BRANCHES, D_MODEL) + merge_bias[layer])
        y = g[:, :, 0] * (a @ w_branch_a[layer]) + g[:, :, 1] * (b @ w_branch_b[layer])
        x = x + y @ w_out[layer]
    return x
```

```cpp
#include <hip/hip_runtime.h>
#include <cstdio>
#include <cstdint>

#ifndef MK_N_LAUNCHES
#define MK_N_LAUNCHES 1
#endif

#define LAS __attribute__((address_space(3)))
#define GAS __attribute__((address_space(1)))
typedef unsigned short u16;
typedef _Float16 f16x8 __attribute__((ext_vector_type(8)));
typedef _Float16 f16x4 __attribute__((ext_vector_type(4)));
typedef _Float16 f16x2 __attribute__((ext_vector_type(2)));
typedef __bf16 bf16x2_t __attribute__((ext_vector_type(2)));
typedef short s16x8 __attribute__((ext_vector_type(8)));
typedef short s16x4 __attribute__((ext_vector_type(4)));
typedef float f32x2 __attribute__((ext_vector_type(2)));
typedef float f32x4 __attribute__((ext_vector_type(4)));
typedef float f32x16 __attribute__((ext_vector_type(16)));
typedef unsigned u32x2 __attribute__((ext_vector_type(2)));
typedef unsigned u32x4 __attribute__((ext_vector_type(4)));
typedef unsigned short us2 __attribute__((ext_vector_type(2)));

constexpr int BATCH = 8, SEQ = 4096, DM = 1024, M = BATCH * SEQ;
constexpr int DIN = 4648, NPAD = 4864;
constexpr float EPS = 1e-6f;
constexpr float C2 = 0.125f * 1.4426950408889634f;

__device__ __forceinline__ unsigned pk_f16(float a, float b) { f32x2 v = {a, b}; f16x2 h = __builtin_convertvector(v, f16x2); return __builtin_bit_cast(unsigned, h); }
__device__ __forceinline__ unsigned pk_bf16(float a, float b) { f32x2 v = {a, b}; bf16x2_t h = __builtin_convertvector(v, bf16x2_t); return __builtin_bit_cast(unsigned, h); }
__device__ __forceinline__ float f16lo(unsigned u) { f16x2 h = __builtin_bit_cast(f16x2, u); return (float)h.x; }
__device__ __forceinline__ float f16hi(unsigned u) { f16x2 h = __builtin_bit_cast(f16x2, u); return (float)h.y; }
__device__ __forceinline__ float silu_f(float x) { return x * __builtin_amdgcn_rcpf(1.0f + __expf(-x)); }
__device__ __forceinline__ float sigm_f(float x) { return __builtin_amdgcn_rcpf(1.0f + __expf(-x)); }

namespace pg8 {
constexpr int BM = 256, BK = 64, HALF = 128, HTB = HALF * BK * 2, STAGE_BYTES = 8 * HTB, NXCD = 8, WGM = 8;
__host__ __device__ __forceinline__ int lds_byte(int r, int c) { const int st = (r >> 4) * 2 + (c >> 5), rr = r & 15, cc = c & 31, ob = rr * 64 + cc * 2; return st * 1024 + (ob ^ (((ob >> 9) & 1) << 5)); }
__host__ __device__ __forceinline__ void stage_rc(int b, int& R, int& C) { const int st = b / 1024, sb = b % 1024, swz = sb ^ (((sb >> 9) & 1) << 5); R = (st >> 1) * 16 + swz / 64; C = (st & 1) * 32 + (swz % 64) / 2; }
__host__ __device__ __forceinline__ int perm32(int rho) { const int n = rho >> 4, i = rho & 15; return 8 * (i >> 2) + 4 * n + (i & 3); }
struct Unit { int pm, pn; };
struct Gemm { const u16* A; const u16* Bt; int M, N, K; };
__device__ __forceinline__ void map_tile(int wgid, int nM, int nN, int& pm, int& pn) {
    const int nwg = nM * nN;
    { const int q = nwg / NXCD, r = nwg % NXCD, xcd = wgid % NXCD, off = wgid / NXCD; wgid = (xcd < r ? xcd * (q + 1) : r * (q + 1) + (xcd - r) * q) + off; }
    const int nig = WGM * nN, gid = wgid / nig, fm = gid * WGM, gsz = (nM - fm) < WGM ? (nM - fm) : WGM;
    pm = fm + ((wgid % nig) % gsz); pn = (wgid % nig) / gsz;
}
struct StaticOrder {
    int nM, nN, nwg, G, c;
    __device__ void init(int M_, int N_, int G_, int c_) { nM = M_ / BM; nN = N_ / BM; nwg = nM * nN; G = G_; c = c_; }
    __device__ bool next(int i, Unit& u) const { const long L = (long)i * G + c; if (L >= nwg) return false; map_tile((int)L, nM, nN, u.pm, u.pn); return true; }
};
struct InProjOrder {
    int G, c;
    __device__ bool next(int i, Unit& u) const { const long L = (long)i * G + c; if (L >= 2432) return false;
        if (L < 2304) { map_tile((int)L, 128, 18, u.pm, u.pn); } else { const int j = (int)L - 2304; u.pm = (j & 7) * 16 + (j >> 3); u.pn = 18; } return true; }
};
struct PairOrder {
    int G, c;
    __device__ bool next(int i, Unit& u) const { const int part = i & 1; const long L = (long)(i >> 1) * G + c; if (L >= 512) return false; int pm, pn; map_tile((int)L, 128, 4, pm, pn); u.pm = pm + 128 * part; u.pn = pn + 4 * part; return true; }
};

template <class Epi, class Sched, int NARROW_PN = -1>
__device__ __forceinline__ void gemm_phase(LAS unsigned char* lds, const Gemm g, const Sched& S, const Epi& E) {
    const int tid = threadIdx.x, wid = __builtin_amdgcn_readfirstlane(tid >> 6), lane = tid & 63, wr = wid >> 2, wc = wid & 3, fr = lane & 15, fq = lane >> 4;
    const int K = g.K, nt = K / BK;
    unsigned voffA[2], voffB[2];
#pragma unroll
    for (int i = 0; i < 2; ++i) { int R, C; stage_rc(tid * 16 + i * 8192, R, C); const int Rb = (R & ~31) + perm32(R & 31);
        voffA[i] = (unsigned)(R * K + C) * 2u; voffB[i] = (unsigned)(Rb * K + C) * 2u; }
    const size_t kstep = (size_t)(BK * 2);
    const size_t hstep = (size_t)HALF * K * 2;
    const size_t tstep = 2 * hstep;
    const unsigned ldsw = (unsigned)wid * 1024u;
    const int aoff = lds_byte(wr * 64 + fr, fq * 8), boff = lds_byte(wc * 32 + fr, fq * 8);
#define PG8_SA(b, h) (((b) * 2 + (h)) * HTB)
#define PG8_SB(b, h) ((4 + (b) * 2 + (h)) * HTB)
#define PG8_STAGE(bufoff, gbase, voff) do { _Pragma("unroll") for (int _i = 0; _i < 2; ++_i) \
        __builtin_amdgcn_global_load_lds((const unsigned*)((const char*)(gbase) + (voff)[_i]), (LAS unsigned*)(lds + (bufoff) + ldsw + _i * 8192), 16, 0, 0); } while (0)
#define PG8_LDA(dst, b, h) do { _Pragma("unroll") for (int m = 0; m < 4; ++m) _Pragma("unroll") for (int k = 0; k < 2; ++k) dst[m][k] = *(const LAS f16x8*)(lds + PG8_SA(b, h) + aoff + m * 2048 + k * 1024); } while (0)
#define PG8_LDB(dst, b, h) do { _Pragma("unroll") for (int n = 0; n < 2; ++n) _Pragma("unroll") for (int k = 0; k < 2; ++k) dst[n][k] = *(const LAS f16x8*)(lds + PG8_SB(b, h) + boff + n * 2048 + k * 1024); } while (0)
#define PG8_MMA(ai, bj, At, Bt) do { __builtin_amdgcn_s_setprio(1); _Pragma("unroll") for (int m = 0; m < 4; ++m) _Pragma("unroll") for (int n = 0; n < 2; ++n) _Pragma("unroll") for (int k = 0; k < 2; ++k) \
        acc[ai][bj][m][n] = __builtin_amdgcn_mfma_f32_16x16x32_f16(Bt[n][k], At[m][k], acc[ai][bj][m][n], 0, 0, 0); __builtin_amdgcn_s_setprio(0); } while (0)
#define PG8_WAIT_V(n) asm volatile("s_waitcnt vmcnt(" #n ")" ::: "memory")
#define PG8_WAIT_L(n) asm volatile("s_waitcnt lgkmcnt(" #n ")" ::: "memory")
#define PG8_BAR __builtin_amdgcn_s_barrier()
#define PG8_SCHED __builtin_amdgcn_sched_barrier(0)
    Unit cur, nxt; int ui = 0;
    if (!S.next(0, cur)) return;
    f32x4 acc[2][2][4][2];
#pragma unroll
    for (int a = 0; a < 2; ++a)
#pragma unroll
        for (int b = 0; b < 2; ++b)
#pragma unroll
            for (int m = 0; m < 4; ++m)
#pragma unroll
                for (int n = 0; n < 2; ++n) acc[a][b][m][n] = (f32x4){0.f, 0.f, 0.f, 0.f};
    f16x8 At[4][2], B0[2][2], B1[2][2];
    const char* cA = (const char*)g.A + (size_t)cur.pm * tstep; const char* cB = (const char*)g.Bt + (size_t)cur.pn * tstep;
    PG8_STAGE(PG8_SB(0, 0), cB, voffB); PG8_STAGE(PG8_SB(0, 1), cB + hstep, voffB); PG8_STAGE(PG8_SA(0, 0), cA, voffA); PG8_STAGE(PG8_SA(0, 1), cA + hstep, voffA);
    if (wr == 1) PG8_BAR;
    PG8_WAIT_V(2); PG8_BAR;
    PG8_STAGE(PG8_SB(1, 0), cB + kstep, voffB); PG8_STAGE(PG8_SA(1, 0), cA + kstep, voffA); PG8_STAGE(PG8_SB(1, 1), cB + hstep + kstep, voffB);
    PG8_WAIT_V(6); PG8_BAR;
    for (;;) {
        const bool has_next = S.next(ui + 1, nxt);
        const bool narrow = (NARROW_PN >= 0) && (cur.pn == NARROW_PN);
        const char* nA = has_next ? (const char*)g.A + (size_t)nxt.pm * tstep : cA; const char* nB = has_next ? (const char*)g.Bt + (size_t)nxt.pn * tstep : cB;
        for (int t = 0; t < nt; t += 2) {
            const bool last = (t == nt - 2);
            const char* a1 = cA + (size_t)(t + 1) * kstep;
            const char* a2 = last ? nA : cA + (size_t)(t + 2) * kstep; const char* b2 = last ? nB : cB + (size_t)(t + 2) * kstep;
            const char* a3 = a2 + kstep; const char* b3 = b2 + kstep;
            PG8_LDB(B0, 0, 0); PG8_LDB(B1, 0, 1); PG8_SCHED; PG8_LDA(At, 0, 0); PG8_STAGE(PG8_SA(1, 1), a1 + hstep, voffA);
            PG8_WAIT_V(8); PG8_WAIT_L(0); PG8_BAR; PG8_MMA(0, 0, At, B0); if (!narrow) PG8_MMA(0, 1, At, B1); PG8_BAR; PG8_SCHED;
            PG8_LDA(At, 0, 1); PG8_STAGE(PG8_SB(0, 0), b2, voffB); PG8_STAGE(PG8_SB(0, 1), b2 + hstep, voffB); PG8_STAGE(PG8_SA(0, 0), a2, voffA);
            PG8_WAIT_V(8); PG8_WAIT_L(0); PG8_BAR; PG8_MMA(1, 0, At, B0); if (!narrow) PG8_MMA(1, 1, At, B1); PG8_BAR; PG8_SCHED;
            PG8_LDB(B0, 1, 0); PG8_LDB(B1, 1, 1); PG8_SCHED; PG8_LDA(At, 1, 0); PG8_STAGE(PG8_SA(0, 1), a2 + hstep, voffA);
            PG8_WAIT_V(8); PG8_WAIT_L(0); PG8_BAR; PG8_MMA(0, 0, At, B0); if (!narrow) PG8_MMA(0, 1, At, B1); PG8_BAR; PG8_SCHED;
            PG8_LDA(At, 1, 1); PG8_STAGE(PG8_SB(1, 0), b3, voffB); PG8_STAGE(PG8_SB(1, 1), b3 + hstep, voffB); PG8_STAGE(PG8_SA(1, 0), a3, voffA);
            PG8_WAIT_V(8); PG8_WAIT_L(0); PG8_BAR; PG8_MMA(1, 0, At, B0); if (!narrow) PG8_MMA(1, 1, At, B1); PG8_BAR; PG8_SCHED;
        }
        if (wr == 0) PG8_BAR;
        bool keep; { int fr_ = fr, fq_ = fq; asm volatile("" : "+v"(fr_), "+v"(fq_)); keep = E(acc, cur, wr, wc, fr_, fq_); }
        if (!has_next) break;
        if (!keep) {
#pragma unroll
        for (int a = 0; a < 2; ++a)
#pragma unroll
            for (int b = 0; b < 2; ++b)
#pragma unroll
                for (int m = 0; m < 4; ++m)
#pragma unroll
                    for (int n = 0; n < 2; ++n) acc[a][b][m][n] = (f32x4){0.f, 0.f, 0.f, 0.f};
        }
        cur = nxt; cA = nA; cB = nB; ++ui;
        if (wr == 1) PG8_BAR;
    }
    PG8_WAIT_V(0);
    PG8_BAR;
#undef PG8_SA
#undef PG8_SB
#undef PG8_STAGE
#undef PG8_LDA
#undef PG8_LDB
#undef PG8_MMA
#undef PG8_WAIT_V
#undef PG8_WAIT_L
#undef PG8_BAR
#undef PG8_SCHED
}
}

constexpr size_t MiB = 1u << 20;
constexpr size_t WS_CTL = 0, CTL_ZERO_BYTES = 32768;
constexpr size_t WS_WIN = 2 * MiB;
constexpr size_t WS_WAB = 12 * MiB;
constexpr size_t WS_WOUT = 14 * MiB;
constexpr size_t WS_POOL = 16 * MiB;
constexpr size_t WS_RSTD = 16 * MiB + 512 * 1024;
constexpr size_t WS_ROPEA = 17 * MiB;
constexpr size_t WS_ROPEI = 19 * MiB;
constexpr size_t WS_WI = 20 * MiB;
constexpr size_t WS_KI = 21 * MiB;
constexpr size_t WS_KB = 24 * MiB;
constexpr size_t WS_VB = 32 * MiB;
constexpr size_t WS_QI = 40 * MiB;
constexpr size_t WS_MASK = 56 * MiB;
constexpr size_t WS_QB = 72 * MiB;
constexpr size_t WS_ZA = 104 * MiB;
constexpr size_t WS_ZB = 136 * MiB;
constexpr size_t WS_UB = 168 * MiB;
constexpr size_t WS_GT = 200 * MiB;
constexpr size_t WS_XH = 328 * MiB;
constexpr size_t WS_Y = 392 * MiB;
constexpr size_t WS_END = 456 * MiB;
constexpr int CW_BAR = 4096;
static_assert((4096 + 3456) * 4 <= 32768, "control words inside the memset region");
constexpr int CW_KMAX = 2048;
constexpr int CW_Q = 3400;

constexpr int RING_BYTES = 131072;
constexpr int LDSCTL_OFF = RING_BYTES, MISC_OFF = LDSCTL_OFF + 320;
constexpr int LDS_BYTES = 163840;

#define XB_TMO      128
#define XB_XCNT(j)  (256  + 64 * (j))
#define XB_XSUB(j)  (1280 + 64 * (j))
#define XB_XGEN(j)  (2304 + 64 * (j))
#define XB_TOP      3328
#define XB_TOPGEN   3392
#define XCD_BAR_WORDS 3456
#define XB_SPIN_CAP (1u << 18)
__device__ __forceinline__ unsigned xb_ld(unsigned* p)              { return __hip_atomic_load(p, __ATOMIC_RELAXED, __HIP_MEMORY_SCOPE_AGENT); }
__device__ __forceinline__ unsigned xb_add(unsigned* p, unsigned v) { return __hip_atomic_fetch_add(p, v, __ATOMIC_RELAXED, __HIP_MEMORY_SCOPE_AGENT); }
__device__ __forceinline__ unsigned xb_xcc_id() { return (unsigned)__builtin_amdgcn_s_getreg((3 << 11) | 20) & 0xFu; }
#define XB_SPIN(cond, bar) do { unsigned _sp = 0; while (cond) { __builtin_amdgcn_s_sleep(1); \
    if ((++_sp & 255u) == 0u) { if (xb_ld(&(bar)[XB_TMO])) break; if (_sp > XB_SPIN_CAP) { atomicAdd(&(bar)[XB_TMO], 1u); break; } } } } while (0)
struct XcdBarrier { unsigned* bar; unsigned x; volatile LAS unsigned* st; };
__device__ __forceinline__ XcdBarrier xcd_barrier_post(unsigned* bar, volatile LAS unsigned* st) {
    XcdBarrier b; b.bar = bar; b.x = xb_xcc_id(); b.st = st;
    if (threadIdx.x == 0) (void)xb_add(&bar[XB_XCNT(b.x)], 1u);
    return b;
}
__device__ __forceinline__ void xcd_barrier_complete(unsigned* bar, unsigned x, unsigned& nloc, unsigned& nx) {
    const unsigned G = gridDim.x * gridDim.y * gridDim.z;
    unsigned sum, cnt, mine, sp = 0u;
    for (;;) {
        sum = 0u; cnt = 0u; mine = 0u;
#pragma unroll
        for (unsigned j = 0; j < 16; ++j) { const unsigned c = xb_ld(&bar[XB_XCNT(j)]); sum += c; cnt += (c > 0u) ? 1u : 0u; mine = (j == x) ? c : mine; }
        if (sum == G) break;
        __builtin_amdgcn_s_sleep(1);
        if ((++sp & 255u) == 0u) { if (xb_ld(&bar[XB_TMO])) break; if (sp > XB_SPIN_CAP) { atomicAdd(&bar[XB_TMO], 1u); break; } }
    }
    nloc = mine > 0u ? mine : 1u; nx = cnt > 0u ? cnt : 1u;
}
__device__ __forceinline__ void xcd_barrier(const XcdBarrier& b) {
    asm volatile("s_waitcnt vmcnt(0)" ::: "memory");
    __syncthreads();
    if (threadIdx.x == 0) {
        unsigned* bar = b.bar;
        __builtin_amdgcn_s_waitcnt(0);
        unsigned nloc = b.st[0], nx = b.st[1];
        if (nloc == 0u) { xcd_barrier_complete(bar, b.x, nloc, nx); b.st[0] = nloc; b.st[1] = nx; }
        const unsigned old = xb_add(&bar[XB_XSUB(b.x)], 1u);
        const unsigned gen = old / nloc;
        if (old + 1u == (gen + 1u) * nloc) {
            __builtin_amdgcn_fence(__ATOMIC_RELEASE, "agent");
            asm volatile("s_waitcnt vmcnt(0)" ::: "memory");
            const unsigned og = xb_add(&bar[XB_TOP], 1u);
            const unsigned tg = og / nx;
            if (og + 1u == (tg + 1u) * nx) xb_add(&bar[XB_TOPGEN], 1u);
            else XB_SPIN(xb_ld(&bar[XB_TOPGEN]) == tg, bar);
            __builtin_amdgcn_fence(__ATOMIC_ACQUIRE, "agent");
            xb_add(&bar[XB_XGEN(b.x)], 1u);
            asm volatile("s_waitcnt vmcnt(0)" ::: "memory");
        } else {
            XB_SPIN(xb_ld(&bar[XB_XGEN(b.x)]) == gen, bar);
            __builtin_amdgcn_fence(__ATOMIC_ACQUIRE, "agent");
            asm volatile("s_waitcnt vmcnt(0)" ::: "memory");
        }
    }
    __syncthreads();
}

struct Frame {
    LAS unsigned char* lds;
    int tid, lane, wave, vcu, G;
    const float *x, *norm_g, *w_in, *mbias, *qng, *kng, *pool_w, *pool_scale, *wba, *wbb, *wout; const int* pos;
    float* out; unsigned char* ws;
};
#define LDS_WAIT() asm volatile("s_waitcnt lgkmcnt(0)" ::: "memory")
#define LDS_ADD(p, v) __hip_atomic_fetch_add((LAS unsigned*)(p), (v), __ATOMIC_RELAXED, __HIP_MEMORY_SCOPE_WORKGROUP)
#define LDS_OR(p, v) __hip_atomic_fetch_or((LAS unsigned*)(p), (v), __ATOMIC_RELAXED, __HIP_MEMORY_SCOPE_WORKGROUP)


#define QUEUE_LOOP(F, qhead, N, u, ...) do { volatile LAS unsigned* qslot_ = (volatile LAS unsigned*)((F).lds + MISC_OFF); unsigned* qh_ = (qhead); \
    unsigned nxt_ = 0u; if ((F).tid == 0) nxt_ = __hip_atomic_fetch_add(qh_, 1u, __ATOMIC_RELAXED, __HIP_MEMORY_SCOPE_AGENT); \
    for (;;) { if ((F).tid == 0) qslot_[0] = nxt_; __syncthreads(); const int u = (int)qslot_[0]; if (u >= (N)) break; \
        if ((F).tid == 0) nxt_ = __hip_atomic_fetch_add(qh_, 1u, __ATOMIC_RELAXED, __HIP_MEMORY_SCOPE_AGENT); __VA_ARGS__; } \
    __syncthreads(); } while (0)
#define BATCH_QUEUE_LOOP(F, qbase, N, b0, bb, u, ...) do { volatile LAS unsigned* qslot_ = (volatile LAS unsigned*)((F).lds + MISC_OFF); unsigned* qb_ = (qbase); \
    int curb_ = (b0); unsigned nxt_ = 0u; if ((F).tid == 0) nxt_ = __hip_atomic_fetch_add(qb_ + 16 * curb_, 1u, __ATOMIC_RELAXED, __HIP_MEMORY_SCOPE_AGENT); \
    for (;;) { \
        if ((F).tid == 0) { \
            while (nxt_ >= (unsigned)(N)) { int best_ = -1; unsigned bh_ = (unsigned)(N); \
                for (int q_ = 0; q_ < 8; ++q_) { const unsigned h_ = __hip_atomic_load(qb_ + 16 * q_, __ATOMIC_RELAXED, __HIP_MEMORY_SCOPE_AGENT); if (h_ < bh_) { bh_ = h_; best_ = q_; } } \
                if (best_ < 0) break; curb_ = best_; nxt_ = __hip_atomic_fetch_add(qb_ + 16 * curb_, 1u, __ATOMIC_RELAXED, __HIP_MEMORY_SCOPE_AGENT); } \
            qslot_[0] = nxt_; qslot_[1] = (unsigned)curb_; } \
        __syncthreads(); const int u = (int)qslot_[0]; const int bb = (int)qslot_[1]; if (u >= (N)) break; \
        if ((F).tid == 0) nxt_ = __hip_atomic_fetch_add(qb_ + 16 * curb_, 1u, __ATOMIC_RELAXED, __HIP_MEMORY_SCOPE_AGENT); __VA_ARGS__; } \
    __syncthreads(); } while (0)
__device__ __forceinline__ int sigma64(int s) { return (s < 16) ? ((s & 3) + 4 * ((s >> 3) & 1) + 8 * ((s >> 2) & 1)) : s; }
__device__ __forceinline__ int win_src(int cp) {
    const int T = cp >> 8, c = cp & 255, bj = c >> 7, wc = (c >> 5) & 3, s5 = c & 31;
    if (T < 2) return 64 * (4 * T + wc) + sigma64(32 * bj + s5);
    if (T == 2) { if (wc < 2) return 512 + 64 * wc + sigma64(32 * bj + s5); return 640 + 64 * (wc - 2) + 32 * bj + s5; }
    if (T == 3) return 768 + 32 * (2 * wc + bj) + s5;
    if (T < 18) return 1064 + (cp - 1024);
    if (bj == 0 && wc == 0) return 1024 + s5;
    if (bj == 0 && wc == 1 && s5 < 8) return 1056 + s5;
    return -1;
}
template <int MODE>
__device__ __forceinline__ void p0_transpose_item(const float* W, int K, int N, u16* WT, const float* gain, LAS float* scr, int item, int lane) {
    const int nblk_k = K / 64, kb = item % nblk_k, nb = item / nblk_k, k0 = 64 * kb, n0 = 32 * nb;
    const int src = (MODE == 0) ? win_src(n0 + (lane & 31)) : (n0 + (lane & 31));
#pragma unroll 8
    for (int i = 0; i < 32; ++i) { const int kk = 2 * i + (lane >> 5); float v = 0.f; if (src >= 0) v = W[(size_t)(k0 + kk) * N + src]; if (MODE == 0) v *= gain[k0 + kk]; scr[kk * 33 + (lane & 31)] = v; }
    LDS_WAIT(); asm volatile("" ::: "memory");
    const int c = lane & 7;
#pragma unroll
    for (int j = 0; j < 4; ++j) { const int n = (lane >> 3) + 8 * j; const LAS float* s = scr + (8 * c) * 33 + n;
        u32x4 o; o.x = pk_f16(s[0 * 33], s[1 * 33]); o.y = pk_f16(s[2 * 33], s[3 * 33]); o.z = pk_f16(s[4 * 33], s[5 * 33]); o.w = pk_f16(s[6 * 33], s[7 * 33]);
        *(GAS u32x4*)(WT + (size_t)(n0 + n) * K + k0 + 8 * c) = o; }
    LDS_WAIT(); asm volatile("" ::: "memory");
}
__device__ __forceinline__ float wave_sum(float v) {
#pragma unroll
    for (int o = 1; o < 64; o <<= 1) v += __shfl_xor(v, o);
    return v;
}
__device__ __forceinline__ void p0_prologue(Frame& F) {
    LAS float* scr = (LAS float*)(F.lds + F.wave * 16384);
    const int gw = F.vcu * 8 + F.wave, NGW = F.G * 8;
    constexpr int I_IN = (DM / 64) * (NPAD / 32), I_A = (512 / 64) * (1024 / 32), I_O = (1024 / 64) * (1024 / 32), I_P = (128 / 64) * (128 / 32);
    constexpr int NITEMS = I_IN + 2 * I_A + I_O + 4 * I_P;
    for (int it = gw; it < NITEMS; it += NGW) {
        int r = it;
        if (r < I_IN) { p0_transpose_item<0>(F.w_in, DM, DIN, (u16*)(F.ws + WS_WIN), F.norm_g, scr, r, F.lane); continue; } r -= I_IN;
        if (r < I_A) { p0_transpose_item<1>(F.wba, 512, 1024, (u16*)(F.ws + WS_WAB), nullptr, scr, r, F.lane); continue; } r -= I_A;
        if (r < I_A) { p0_transpose_item<1>(F.wbb, 512, 1024, (u16*)(F.ws + WS_WAB) + (size_t)1024 * 512, nullptr, scr, r, F.lane); continue; } r -= I_A;
        if (r < I_O) { p0_transpose_item<1>(F.wout, 1024, 1024, (u16*)(F.ws + WS_WOUT), nullptr, scr, r, F.lane); continue; } r -= I_O;
        const int g = r / I_P; r -= g * I_P;
        p0_transpose_item<1>(F.pool_w + (size_t)g * 128 * 128, 128, 128, (u16*)(F.ws + WS_POOL) + (size_t)g * 128 * 128, nullptr, scr, r, F.lane);
    }
    float* rstd = (float*)(F.ws + WS_RSTD);
    for (int m0 = gw * 4; m0 < M; m0 += NGW * 4) {
        f32x4 v[4][4]; float s[4];
#pragma unroll
        for (int rr = 0; rr < 4; ++rr) { const GAS f32x4* xr = (const GAS f32x4*)(F.x + (size_t)(m0 + rr) * DM) + F.lane;
#pragma unroll
            for (int j = 0; j < 4; ++j) v[rr][j] = __builtin_nontemporal_load(xr + 64 * j); }
#pragma unroll
        for (int rr = 0; rr < 4; ++rr) { float a = 0.f;
#pragma unroll
            for (int j = 0; j < 4; ++j) a += (v[rr][j].x * v[rr][j].x + v[rr][j].y * v[rr][j].y) + (v[rr][j].z * v[rr][j].z + v[rr][j].w * v[rr][j].w);
            s[rr] = a;
            GAS u32x2* o8 = (GAS u32x2*)((u16*)(F.ws + WS_XH) + (size_t)(m0 + rr) * DM) + F.lane;
#pragma unroll
            for (int j = 0; j < 4; ++j) { u32x2 w; w.x = pk_f16(v[rr][j].x, v[rr][j].y); w.y = pk_f16(v[rr][j].z, v[rr][j].w); o8[64 * j] = w; } }
#pragma unroll
        for (int o = 1; o < 64; o <<= 1) {
#pragma unroll
            for (int rr = 0; rr < 4; ++rr) s[rr] += __shfl_xor(s[rr], o); }
        if (F.lane < 4) { const float sv = F.lane == 0 ? s[0] : F.lane == 1 ? s[1] : F.lane == 2 ? s[2] : s[3]; rstd[m0 + F.lane] = rsqrtf(sv * (1.0f / DM) + EPS); }
    }
    {
        float* ra = (float*)(F.ws + WS_ROPEA); float* ri = (float*)(F.ws + WS_ROPEI);
        const int gt = F.vcu * 512 + F.tid, NGT = F.G * 512;
        for (int idx = gt; idx < M * 12; idx += NGT) {
            const int m = idx / 12, i = idx - m * 12;
            const float inv = i == 0 ? 1.000000000e+00f : i == 1 ? 1.939227432e-01f : i == 2 ? 3.760603070e-02f : i == 3 ? 7.292664610e-03f : i == 4 ? 1.414213562e-03f : i == 5 ? 2.742481884e-04f : i == 6 ? 5.318295734e-05f : i == 7 ? 1.031338525e-05f
                            : i == 8 ? 1.000000000e+00f : i == 9 ? 3.760603070e-02f : i == 10 ? 1.414213562e-03f : 5.318295734e-05f;
            const float a = (float)F.pos[m] * inv; float sn, c; sincosf(a, &sn, &c);
            if (i < 8) { ra[(size_t)m * 16 + i] = c; ra[(size_t)m * 16 + 8 + i] = sn; } else { ri[(size_t)m * 8 + (i - 8)] = c; ri[(size_t)m * 8 + 4 + (i - 8)] = sn; }
        }
    }
}

struct EpiIn {
    const float * __restrict__ rstd, * __restrict__ ropeA, * __restrict__ ropeI, * __restrict__ qng, * __restrict__ kng, * __restrict__ mbias;
    u16 * __restrict__ QB, * __restrict__ KB, * __restrict__ VB, * __restrict__ QI, * __restrict__ KI, * __restrict__ ZA, * __restrict__ UB, * __restrict__ ZB, * __restrict__ GT; float* __restrict__ WI; unsigned* kmax;
    template <bool ISQ>
    __device__ __forceinline__ void qk_tile(const f32x4 (&acc)[2][2][4][2], u16* __restrict__ dst, int row0, int fq, const float (&rsv)[2][4]) const {
        const float* gn = ISQ ? qng : kng;
        float gv[2][2][4];
#pragma unroll
        for (int bj = 0; bj < 2; ++bj)
#pragma unroll
            for (int n = 0; n < 2; ++n)
#pragma unroll
                for (int r = 0; r < 4; ++r) gv[bj][n][r] = gn[sigma64(32 * bj + 8 * fq + 4 * n + r)] * (ISQ ? C2 : 1.0f);
        constexpr int pitch = ISQ ? 512 : 128;
#pragma unroll
        for (int ai = 0; ai < 2; ++ai)
#pragma unroll
            for (int m = 0; m < 4; ++m) {
                const int row = row0 + ai * 128 + m * 16; const float rs = rsv[ai][m];
                f32x4 v[2][2]; float ss = 0.f;
#pragma unroll
                for (int bj = 0; bj < 2; ++bj)
#pragma unroll
                    for (int n = 0; n < 2; ++n) { v[bj][n] = acc[ai][bj][m][n] * rs; ss += (v[bj][n].x * v[bj][n].x + v[bj][n].y * v[bj][n].y) + (v[bj][n].z * v[bj][n].z + v[bj][n].w * v[bj][n].w); }
                ss += __shfl_xor(ss, 16); ss += __shfl_xor(ss, 32);
                const float rinv = rsqrtf(ss * (1.0f / 64.0f) + EPS);
#pragma unroll
                for (int bj = 0; bj < 2; ++bj)
#pragma unroll
                    for (int n = 0; n < 2; ++n)
#pragma unroll
                        for (int r = 0; r < 4; ++r) v[bj][n][r] = v[bj][n][r] * rinv * gv[bj][n][r];
                if (fq < 2) {
                    const f32x4 cs = *(const f32x4*)(ropeA + (size_t)row * 16 + 4 * fq), sn = *(const f32x4*)(ropeA + (size_t)row * 16 + 8 + 4 * fq);
                    const f32x4 x1 = v[0][0], x2 = v[0][1];
                    v[0][0] = x1 * cs - x2 * sn; v[0][1] = x1 * sn + x2 * cs;
                }
#pragma unroll
                for (int bj = 0; bj < 2; ++bj) { u32x4 w; w.x = pk_bf16(v[bj][0].x, v[bj][0].y); w.y = pk_bf16(v[bj][0].z, v[bj][0].w); w.z = pk_bf16(v[bj][1].x, v[bj][1].y); w.w = pk_bf16(v[bj][1].z, v[bj][1].w);
                    *(u32x4*)(dst + (size_t)row * pitch + 32 * bj + 8 * fq) = w; }
            }
    }
    template <int MODE>
    __device__ __forceinline__ void act_tile(const f32x4 (&acc)[2][2][4][2], u16* __restrict__ dst, int pitch, int colt, int row0, int wc, int fq, const float (&rsv)[2][4]) const {
        const int col0 = colt + wc * 32 + 8 * fq;
        f32x4 bv[2][2];
#pragma unroll
        for (int bj = 0; bj < 2; ++bj)
#pragma unroll
            for (int n = 0; n < 2; ++n) bv[bj][n] = (MODE == 2) ? *(const f32x4*)(mbias + col0 + bj * 128 + 4 * n) : (f32x4){0.f, 0.f, 0.f, 0.f};
#pragma unroll
        for (int ai = 0; ai < 2; ++ai)
#pragma unroll
            for (int m = 0; m < 4; ++m) { const int row = row0 + ai * 128 + m * 16; const float rs = rsv[ai][m];
#pragma unroll
                for (int bj = 0; bj < 2; ++bj) { f32x4 a = acc[ai][bj][m][0] * rs + bv[bj][0], b = acc[ai][bj][m][1] * rs + bv[bj][1];
                    if (MODE == 1) {
#pragma unroll
                        for (int r = 0; r < 4; ++r) { a[r] = silu_f(a[r]); b[r] = silu_f(b[r]); } }
                    else if (MODE == 2) {
#pragma unroll
                        for (int r = 0; r < 4; ++r) { a[r] = sigm_f(a[r]); b[r] = sigm_f(b[r]); } }
                    u32x4 w; w.x = pk_f16(a.x, a.y); w.y = pk_f16(a.z, a.w); w.z = pk_f16(b.x, b.y); w.w = pk_f16(b.z, b.w);
                    *(u32x4*)(dst + (size_t)row * pitch + col0 + bj * 128) = w; } }
    }
    __device__ __forceinline__ bool operator()(f32x4 (&acc)[2][2][4][2], const pg8::Unit& u, int wr, int wc, int fr, int fq) const {
        const int T = u.pn; const int row0 = u.pm * 256 + wr * 64 + fr;
        float rsv[2][4];
#pragma unroll
        for (int ai = 0; ai < 2; ++ai)
#pragma unroll
            for (int m = 0; m < 4; ++m) rsv[ai][m] = rstd[row0 + ai * 128 + m * 16];
        if (T < 2) { qk_tile<true>(acc, QB + (size_t)(4 * T + wc) * 64, row0, fq, rsv); }
        else if (T == 2 && wc < 2) { qk_tile<false>(acc, KB + (size_t)wc * 64, row0, fq, rsv); }
        else if (T == 2) {
            u16* dst = VB + (size_t)(wc - 2) * 64;
#pragma unroll
            for (int ai = 0; ai < 2; ++ai)
#pragma unroll
                for (int m = 0; m < 4; ++m) { const int row = row0 + ai * 128 + m * 16; const float rs = rsv[ai][m];
#pragma unroll
                    for (int bj = 0; bj < 2; ++bj) { const f32x4 a = acc[ai][bj][m][0] * rs, b = acc[ai][bj][m][1] * rs; u32x4 w; w.x = pk_bf16(a.x, a.y); w.y = pk_bf16(a.z, a.w); w.z = pk_bf16(b.x, b.y); w.w = pk_bf16(b.z, b.w);
                        *(u32x4*)(dst + (size_t)row * 128 + 32 * bj + 8 * fq) = w; } }
        } else if (T == 3) {
            const float sc = 0.17677669529663687f;
#pragma unroll
            for (int ai = 0; ai < 2; ++ai)
#pragma unroll
                for (int m = 0; m < 4; ++m) { const int row = row0 + ai * 128 + m * 16; const float rs = rsv[ai][m] * sc;
                    const f32x4 cs = *(const f32x4*)(ropeI + (size_t)row * 8), sn = *(const f32x4*)(ropeI + (size_t)row * 8 + 4);
#pragma unroll
                    for (int bj = 0; bj < 2; ++bj) { f32x4 a = acc[ai][bj][m][0] * rs, b = acc[ai][bj][m][1] * rs;
                        if (fq == 0) { const f32x4 x1 = a, x2 = b; a = x1 * cs - x2 * sn; b = x1 * sn + x2 * cs; }
                        u32x4 w; w.x = pk_f16(a.x, a.y); w.y = pk_f16(a.z, a.w); w.z = pk_f16(b.x, b.y); w.w = pk_f16(b.z, b.w);
                        *(u32x4*)(QI + (size_t)row * 256 + 32 * (2 * wc + bj) + 8 * fq) = w; } }
        } else if (T < 6) { act_tile<1>(acc, ZA, 512, (T - 4) * 256, row0, wc, fq, rsv);
        } else if (T < 8) { act_tile<0>(acc, UB, 512, (T - 6) * 256, row0, wc, fq, rsv);
        } else if (T < 10) { act_tile<1>(acc, ZB, 512, (T - 8) * 256, row0, wc, fq, rsv);
        } else if (T < 18) { act_tile<2>(acc, GT, 2048, (T - 10) * 256, row0, wc, fq, rsv);
        } else {
            if (wc == 0) {
                float mx = 0.f;
#pragma unroll
                for (int ai = 0; ai < 2; ++ai)
#pragma unroll
                    for (int m = 0; m < 4; ++m) { const int row = row0 + ai * 128 + m * 16; const float rs = rsv[ai][m];
                        const f32x4 cs = *(const f32x4*)(ropeI + (size_t)row * 8), sn = *(const f32x4*)(ropeI + (size_t)row * 8 + 4);
                        f32x4 a = acc[ai][0][m][0] * rs, b = acc[ai][0][m][1] * rs;
                        float ss = (a.x * a.x + a.y * a.y) + (a.z * a.z + a.w * a.w) + (b.x * b.x + b.y * b.y) + (b.z * b.z + b.w * b.w);
                        ss += __shfl_xor(ss, 16); ss += __shfl_xor(ss, 32); mx = fmaxf(mx, ss);
                        if (fq == 0) { const f32x4 x1 = a, x2 = b; a = x1 * cs - x2 * sn; b = x1 * sn + x2 * cs; }
                        u32x4 w; w.x = pk_f16(a.x, a.y); w.y = pk_f16(a.z, a.w); w.z = pk_f16(b.x, b.y); w.w = pk_f16(b.z, b.w);
                        *(u32x4*)(KI + (size_t)row * 32 + 8 * fq) = w; }
#pragma unroll
                for (int o = 1; o < 16; o <<= 1) mx = fmaxf(mx, __shfl_xor(mx, o));
                if ((threadIdx.x & 63) == 0) __hip_atomic_fetch_max(kmax + 64 * (u.pm >> 4), __float_as_uint(mx), __ATOMIC_RELAXED, __HIP_MEMORY_SCOPE_AGENT);
            } else if (wc == 1 && fq == 0) {
                const float sc = 0.35355339059327373f;
#pragma unroll
                for (int ai = 0; ai < 2; ++ai)
#pragma unroll
                    for (int m = 0; m < 4; ++m) { const int row = row0 + ai * 128 + m * 16; const float rs = rsv[ai][m] * sc;
                        *(f32x4*)(WI + (size_t)row * 8) = acc[ai][0][m][0] * rs; *(f32x4*)(WI + (size_t)row * 8 + 4) = acc[ai][0][m][1] * rs; }
            }
        }
        return false;
    }
};

struct EpiBranch {
    const u16* __restrict__ GT; u16* __restrict__ Y;
    __device__ __forceinline__ bool operator()(f32x4 (&acc)[2][2][4][2], const pg8::Unit& u, int wr, int wc, int fr, int fq) const {
        const int part = u.pm >= 128 ? 1 : 0; const int pm = u.pm & 127, pn = u.pn & 3;
        const int row0 = pm * 256 + wr * 64 + fr, col0 = pn * 256 + wc * 32 + 8 * fq;
#pragma unroll
        for (int ai = 0; ai < 2; ++ai) {
            u32x4 gbv[4][2], gav[4][2];
#pragma unroll
            for (int m = 0; m < 4; ++m)
#pragma unroll
                for (int bj = 0; bj < 2; ++bj) { const size_t go = (size_t)(row0 + ai * 128 + m * 16) * 2048 + col0 + bj * 128;
                    gbv[m][bj] = *(const u32x4*)(GT + go + 1024); if (part == 0) gav[m][bj] = *(const u32x4*)(GT + go); }
#pragma unroll
            for (int m = 0; m < 4; ++m) { const int row = row0 + ai * 128 + m * 16;
#pragma unroll
                for (int bj = 0; bj < 2; ++bj) { const int col = col0 + bj * 128;
                    const u32x4 gb = gbv[m][bj];
                    const f32x4 b0 = {f16lo(gb.x), f16hi(gb.x), f16lo(gb.y), f16hi(gb.y)}, b1 = {f16lo(gb.z), f16hi(gb.z), f16lo(gb.w), f16hi(gb.w)};
                    if (part == 0) {
                        const u32x4 ga = gav[m][bj];
                        const f32x4 a0 = {f16lo(ga.x), f16hi(ga.x), f16lo(ga.y), f16hi(ga.y)}, a1 = {f16lo(ga.z), f16hi(ga.z), f16lo(ga.w), f16hi(ga.w)};
#pragma unroll
                        for (int r = 0; r < 4; ++r) { acc[ai][bj][m][0][r] *= a0[r] * __builtin_amdgcn_rcpf(fmaxf(b0[r], 6e-8f)); acc[ai][bj][m][1][r] *= a1[r] * __builtin_amdgcn_rcpf(fmaxf(b1[r], 6e-8f)); }
                    } else {
                        const f32x4 a = acc[ai][bj][m][0] * b0, b = acc[ai][bj][m][1] * b1;
                        u32x4 w; w.x = pk_f16(a.x, a.y); w.y = pk_f16(a.z, a.w); w.z = pk_f16(b.x, b.y); w.w = pk_f16(b.z, b.w);
                        *(u32x4*)(Y + (size_t)row * 1024 + col) = w; } } }
        }
        return part == 0;
    }
};
struct EpiOut {
    const u16* __restrict__ XH; float* __restrict__ O;
    __device__ __forceinline__ bool operator()(f32x4 (&acc)[2][2][4][2], const pg8::Unit& u, int wr, int wc, int fr, int fq) const {
        const int row0 = u.pm * 256 + wr * 64 + fr, col0 = u.pn * 256 + wc * 32 + 8 * fq;
#pragma unroll
        for (int ai = 0; ai < 2; ++ai) {
            u32x4 xv[4][2];
#pragma unroll
            for (int m = 0; m < 4; ++m)
#pragma unroll
                for (int bj = 0; bj < 2; ++bj) xv[m][bj] = *(const u32x4*)(XH + (size_t)(row0 + ai * 128 + m * 16) * 1024 + col0 + bj * 128);
#pragma unroll
            for (int m = 0; m < 4; ++m)
#pragma unroll
                for (int bj = 0; bj < 2; ++bj) { const size_t off = (size_t)(row0 + ai * 128 + m * 16) * 1024 + col0 + bj * 128; const u32x4 xw = xv[m][bj];
                    f32x4 o0 = (f32x4){f16lo(xw.x), f16hi(xw.x), f16lo(xw.y), f16hi(xw.y)} + acc[ai][bj][m][0];
                    const f32x4 o1 = (f32x4){f16lo(xw.z), f16hi(xw.z), f16lo(xw.w), f16hi(xw.w)} + acc[ai][bj][m][1];
                    *(f32x4*)(O + off) = o0; *(f32x4*)(O + off + 4) = o1; }
        }
        return false;
    }
};

constexpr int TK_ROW = 8192;
constexpr int TK_HIST8 = RING_BYTES + 1024;
static_assert(16 * TK_ROW <= RING_BYTES && TK_HIST8 + 16384 <= LDS_BYTES && MISC_OFF + 128 <= TK_HIST8, "top-k LDS map");
__device__ __forceinline__ void tk_mfma(f32x4 (&d)[9], const f16x8 kf, const f16x8 (&qf)[8], const f16x8 lhi, const f16x8 llo) {
#pragma unroll
    for (int h = 0; h < 8; ++h) d[h] = __builtin_amdgcn_mfma_f32_16x16x32_f16(kf, qf[h], (f32x4){0.f, 0.f, 0.f, 0.f}, 0, 0, 0);
    d[8] = __builtin_amdgcn_mfma_f32_16x16x32_f16(kf, lhi, (f32x4){0.f, 0.f, 0.f, 0.f}, 0, 0, 0);
    (void)llo;
}
__device__ __forceinline__ void tk_reduce(float (&sc)[4], const f32x4 (&d)[9], const float (&w2)[8]) {
    float a0 = d[8][0], a1 = d[8][1], a2 = d[8][2], a3 = d[8][3];
#pragma unroll
    for (int h = 0; h < 8; ++h) {
        a0 = __builtin_fmaf(w2[h], __builtin_fabsf(d[h][0]), a0); asm volatile("" : "+v"(a0));
        a1 = __builtin_fmaf(w2[h], __builtin_fabsf(d[h][1]), a1); asm volatile("" : "+v"(a1));
        a2 = __builtin_fmaf(w2[h], __builtin_fabsf(d[h][2]), a2); asm volatile("" : "+v"(a2));
        a3 = __builtin_fmaf(w2[h], __builtin_fabsf(d[h][3]), a3); asm volatile("" : "+v"(a3));
    }
    sc[0] = a0; sc[1] = a1; sc[2] = a2; sc[3] = a3;
}
__device__ __forceinline__ unsigned tk_key(float s, float scale, float off) { const unsigned q = (unsigned)__builtin_fmaf(s, scale, off); return q > 65535u ? 65535u : q; }
__device__ __forceinline__ void tk_find_bin(const LAS unsigned* hist, unsigned target, int lane, unsigned& bin, unsigned& above, unsigned& atbin) {
    const u32x4 c = *(const LAS u32x4*)(hist + 4 * lane);
    const unsigned s_ = (c.x + c.y) + (c.z + c.w);
    unsigned S = s_;
#pragma unroll
    for (int o = 1; o < 64; o <<= 1) { const unsigned v = __shfl_down(S, o); if (lane + o < 64) S += v; }
    const unsigned A = S - s_;
    const unsigned long long bal = __ballot(A < target && S >= target);
    const int L0 = bal ? __builtin_ctzll(bal) : 0;
    unsigned bn = 4 * lane, ab = A, at = c.x;
    { unsigned cum = A; bool f = false;
      if (cum + c.w >= target) { bn = 4 * lane + 3; ab = cum; at = c.w; f = true; } cum += c.w;
      if (!f && cum + c.z >= target) { bn = 4 * lane + 2; ab = cum; at = c.z; f = true; } cum += c.z;
      if (!f && cum + c.y >= target) { bn = 4 * lane + 1; ab = cum; at = c.y; f = true; } cum += c.y;
      if (!f) { bn = 4 * lane; ab = cum; at = c.x; } }
    bin = (unsigned)__builtin_amdgcn_readlane((int)bn, L0); above = (unsigned)__builtin_amdgcn_readlane((int)ab, L0); atbin = (unsigned)__builtin_amdgcn_readlane((int)at, L0);
}
#define TK_SCAN(X, T1v, ACC) do { _Pragma("unroll") for (int r = 0; r < NR; ++r) { unsigned d_; asm volatile("v_pk_sub_u16 %0, %2, %3 clamp\n\tv_pk_min_u16 %0, %0, %4\n\tv_pk_add_u16 %1, %1, %0" : "=&v"(d_), "+v"(ACC) : "v"(X[r]), "v"(T1v), "v"(one2)); } } while (0)
template <int NR>
__device__ __forceinline__ void tk_select2(LAS unsigned char* rowa, LAS unsigned* hista, int q, int L, int lane, unsigned* growa) {
    const int nblk = L / 64; LAS unsigned char* rowb = rowa + TK_ROW; LAS unsigned* histb = hista + 256; unsigned* growb = growa + 128;
    for (int o = 2 * L + lane * 16; o < NR * 256; o += 1024) { *(LAS u32x4*)(rowa + o) = (u32x4){0u, 0u, 0u, 0u}; *(LAS u32x4*)(rowb + o) = (u32x4){0u, 0u, 0u, 0u}; }
    *(LAS u32x4*)(hista + 4 * lane) = (u32x4){0u, 0u, 0u, 0u}; *(LAS u32x4*)(histb + 4 * lane) = (u32x4){0u, 0u, 0u, 0u};
    asm volatile("s_waitcnt lgkmcnt(0)" ::: "memory");
    unsigned xa[NR], xb[NR];
    const LAS u16* kpa = (const LAS u16*)(rowa + (((lane >> 2) ^ q) << 3) + ((lane & 3) << 1));
    const LAS u16* kpb = (const LAS u16*)(rowb + (((lane >> 2) ^ (q + 1)) << 3) + ((lane & 3) << 1));
#pragma unroll
    for (int r = 0; r < NR; ++r) { xa[r] = (unsigned)kpa[64 * (2 * r)] | ((unsigned)kpa[64 * (2 * r + 1)] << 16); xb[r] = (unsigned)kpb[64 * (2 * r)] | ((unsigned)kpb[64 * (2 * r + 1)] << 16); }
    const unsigned one2 = 0x00010001u;
#define TK_TOT(C, TOT) do { TOT = 0u; _Pragma("unroll") for (int b2 = 0; b2 < 7; ++b2) TOT += (unsigned)__builtin_popcountll(__ballot(((C) >> b2) & 1u)) << b2; } while (0)
#define TK_FULL(TRA, TRB, TOTA, TOTB) do { const unsigned T1a_ = ((TRA) - 1u) * 0x00010001u, T1b_ = ((TRB) - 1u) * 0x00010001u; unsigned acca_ = 0u, accb_ = 0u; \
        _Pragma("unroll") for (int r = 0; r < NR; ++r) { unsigned da_, db_; \
            asm volatile("v_pk_sub_u16 %0, %4, %6 clamp\n\tv_pk_sub_u16 %1, %5, %7 clamp\n\tv_pk_min_u16 %0, %0, %8\n\tv_pk_min_u16 %1, %1, %8\n\tv_pk_add_u16 %2, %2, %0\n\tv_pk_add_u16 %3, %3, %1" \
                         : "=&v"(da_), "=&v"(db_), "+v"(acca_), "+v"(accb_) : "v"(xa[r]), "v"(xb[r]), "v"(T1a_), "v"(T1b_), "v"(one2)); } \
        const unsigned ca_ = (acca_ & 0xFFFFu) + (acca_ >> 16), cb_ = (accb_ & 0xFFFFu) + (accb_ >> 16); TK_TOT(ca_, TOTA); TK_TOT(cb_, TOTB); } while (0)
    unsigned Ha, Hb, ab1a = 0u, ab1b = 0u;
    {
        const unsigned ksamp = (unsigned)((256 * 128) / L) > 0u ? (unsigned)((256 * 128) / L) : 1u;
        unsigned sa = 0u, sb = 0u;
#pragma unroll 1
        for (int bit = 15; bit >= 8; --bit) { const unsigned tra = sa | (1u << bit), trb = sb | (1u << bit);
            const unsigned T1a_ = (tra - 1u) * 0x00010001u, T1b_ = (trb - 1u) * 0x00010001u; unsigned da_, db_;
            asm volatile("v_pk_sub_u16 %0, %2, %4 clamp\n\tv_pk_sub_u16 %1, %3, %5 clamp\n\tv_pk_min_u16 %0, %0, %6\n\tv_pk_min_u16 %1, %1, %6" : "=&v"(da_), "=&v"(db_) : "v"(xa[0]), "v"(xb[0]), "v"(T1a_), "v"(T1b_), "v"(one2));
            const unsigned ca_ = (da_ & 0xFFFFu) + (da_ >> 16), cb_ = (db_ & 0xFFFFu) + (db_ >> 16);
            const unsigned tota = (unsigned)__builtin_popcountll(__ballot(ca_ & 1u)) + 2u * (unsigned)__builtin_popcountll(__ballot(ca_ & 2u));
            const unsigned totb = (unsigned)__builtin_popcountll(__ballot(cb_ & 1u)) + 2u * (unsigned)__builtin_popcountll(__ballot(cb_ & 2u));
            if (tota >= ksamp) sa = tra; if (totb >= ksamp) sb = trb; }
        Ha = sa >> 8; Hb = sb >> 8;
        if (Ha == 0u) Ha = 1u; if (Hb == 0u) Hb = 1u;
        unsigned cloa, clob; TK_FULL(Ha << 8, Hb << 8, cloa, clob);
        bool knowa = false, knowb = false, donea = false, doneb = false;
#pragma unroll 1
        for (int guard = 0; guard < 600 && !(donea && doneb); ++guard) {
            unsigned tra, trb; int modea, modeb;
            if (donea) { modea = 0; tra = 1u; } else if (cloa < 256u) { if (Ha <= 1u) { Ha = 0u; cloa = 256u; modea = 0; tra = 1u; } else { modea = 1; tra = (Ha - 1u) << 8; } } else if (!knowa) { if (Ha >= 255u) { ab1a = 0u; knowa = true; modea = 0; tra = 1u; } else { modea = 2; tra = (Ha + 1u) << 8; } } else { modea = 0; tra = 1u; }
            if (doneb) { modeb = 0; trb = 1u; } else if (clob < 256u) { if (Hb <= 1u) { Hb = 0u; clob = 256u; modeb = 0; trb = 1u; } else { modeb = 1; trb = (Hb - 1u) << 8; } } else if (!knowb) { if (Hb >= 255u) { ab1b = 0u; knowb = true; modeb = 0; trb = 1u; } else { modeb = 2; trb = (Hb + 1u) << 8; } } else { modeb = 0; trb = 1u; }
            if (modea | modeb) { unsigned ra_, rb_; TK_FULL(tra, trb, ra_, rb_);
                if (modea == 1) { ab1a = cloa; knowa = true; cloa = ra_; --Ha; } else if (modea == 2) { if (ra_ >= 256u) { cloa = ra_; ++Ha; } else { ab1a = ra_; knowa = true; } }
                if (modeb == 1) { ab1b = clob; knowb = true; clob = rb_; --Hb; } else if (modeb == 2) { if (rb_ >= 256u) { clob = rb_; ++Hb; } else { ab1b = rb_; knowb = true; } } }
            donea = cloa >= 256u && knowa; doneb = clob >= 256u && knowb;
        }
    }
#undef TK_FULL
#undef TK_TOT
#pragma unroll
    for (int r = 0; r < NR; ++r) {
        if (((xa[r] >> 8) & 0xFFu) == Ha) LDS_ADD(hista + (xa[r] & 0xFFu), 1u); if ((xa[r] >> 24) == Ha) LDS_ADD(hista + ((xa[r] >> 16) & 0xFFu), 1u);
        if (((xb[r] >> 8) & 0xFFu) == Hb) LDS_ADD(histb + (xb[r] & 0xFFu), 1u); if ((xb[r] >> 24) == Hb) LDS_ADD(histb + ((xb[r] >> 16) & 0xFFu), 1u); }
    asm volatile("s_waitcnt lgkmcnt(0)" ::: "memory");
    unsigned Lba, ab2a, Lbb, ab2b, tiesa, tiesb; tk_find_bin(hista, 256u - ab1a, lane, Lba, ab2a, tiesa); tk_find_bin(histb, 256u - ab1b, lane, Lbb, ab2b, tiesb);
    const unsigned tfa = (Ha << 8) | Lba, tfb = (Hb << 8) | Lbb;
    unsigned needa = 256u - (ab1a + ab2a), needb = 256u - (ab1b + ab2b);
    unsigned mloa = 0u, mhia = 0u, mlob = 0u, mhib = 0u;
#define TK_BLK(X, TF, NEED, MLO, MHI) do { const unsigned key = hf ? (X[r] >> 16) : (X[r] & 0xFFFFu); \
        unsigned long long bs = __ballot(key > TF); unsigned long long bt = __ballot(key == TF); \
        if (bt) { const unsigned nt = (unsigned)__builtin_popcountll(bt); \
            if (nt <= NEED) { bs |= bt; NEED -= nt; } \
            else { while (NEED) { const int p = __builtin_ctzll(bt); bs |= 1ull << p; bt &= bt - 1ull; --NEED; } } } \
        { const unsigned blo = (unsigned)bs, bhi = (unsigned)(bs >> 32); \
          asm volatile("v_writelane_b32 %0, %2, %4\n\tv_writelane_b32 %1, %3, %4" : "+v"(MLO), "+v"(MHI) : "s"(blo), "s"(bhi), "i"(2 * r + hf)); } } while (0)
    if (tiesa == needa && tiesb == needb) {
#pragma unroll
        for (int r = 0; r < NR; ++r)
#pragma unroll
            for (int hf = 0; hf < 2; ++hf) {
                const unsigned long long ba = __ballot((hf ? (xa[r] >> 16) : (xa[r] & 0xFFFFu)) >= tfa), bb = __ballot((hf ? (xb[r] >> 16) : (xb[r] & 0xFFFFu)) >= tfb);
                const unsigned alo = (unsigned)ba, ahi = (unsigned)(ba >> 32), blo = (unsigned)bb, bhi = (unsigned)(bb >> 32);
                asm volatile("v_writelane_b32 %0, %4, %8\n\tv_writelane_b32 %1, %5, %8\n\tv_writelane_b32 %2, %6, %8\n\tv_writelane_b32 %3, %7, %8" : "+v"(mloa), "+v"(mhia), "+v"(mlob), "+v"(mhib) : "s"(alo), "s"(ahi), "s"(blo), "s"(bhi), "i"(2 * r + hf)); }
    } else {
#pragma unroll
        for (int r = 0; r < NR; ++r)
#pragma unroll
            for (int hf = 0; hf < 2; ++hf) { TK_BLK(xa, tfa, needa, mloa, mhia); TK_BLK(xb, tfb, needb, mlob, mhib); }
    }
#undef TK_BLK
    if (lane < nblk) { *(u32x2*)(growa + 2 * lane) = (u32x2){mloa, mhia}; *(u32x2*)(growb + 2 * lane) = (u32x2){mlob, mhib}; }
}
#undef TK_SCAN
__device__ __forceinline__ void topk_unit(Frame& F, int b, int qg) {
    LAS unsigned char* lds = F.lds;
    const int tid = F.tid, lane = F.lane, wave = F.wave;
    const int q0 = 16 * qg, L = 64 * ((q0 >> 6) + 1), t0 = b * SEQ + q0;
    unsigned* gmask = (unsigned*)(F.ws + WS_MASK);
    __syncthreads();
    if (L <= 256) {
#pragma unroll
        for (int rr = 0; rr < 4; ++rr) { const int q = (tid >> 7) + 4 * rr, wd = tid & 127; if (wd < L / 32) gmask[(size_t)(t0 + q) * 128 + wd] = 0xFFFFFFFFu; }
        return;
    }
    const int j = lane & 15, fq = lane >> 4;
    const u16* QI = (const u16*)(F.ws + WS_QI); const u16* KI = (const u16*)(F.ws + WS_KI); const float* WI = (const float*)(F.ws + WS_WI);
    f16x8 qf[8]; float w2[8]; f16x8 lhi, llo;
    float rsum = 0.f;
    {
        const f32x4 wa = *(const f32x4*)(WI + (size_t)(t0 + j) * 8), wb = *(const f32x4*)(WI + (size_t)(t0 + j) * 8 + 4);
        w2[0] = 0.5f * wa.x; w2[1] = 0.5f * wa.y; w2[2] = 0.5f * wa.z; w2[3] = 0.5f * wa.w; w2[4] = 0.5f * wb.x; w2[5] = 0.5f * wb.y; w2[6] = 0.5f * wb.z; w2[7] = 0.5f * wb.w;
        float lv[8];
#pragma unroll
        for (int e = 0; e < 8; ++e) lv[e] = 0.f;
#pragma unroll
        for (int h = 0; h < 8; ++h) { qf[h] = *(const f16x8*)(QI + (size_t)(t0 + j) * 256 + 32 * h + 8 * fq);
            float ss = 0.f;
#pragma unroll
            for (int e = 0; e < 8; ++e) { const float v = (float)qf[h][e]; ss += v * v; lv[e] = __builtin_fmaf(w2[h], v, lv[e]); }
            ss += __shfl_xor(ss, 16); ss += __shfl_xor(ss, 32);
            rsum += 2.0f * fabsf(w2[h]) * sqrtf(ss); }
#pragma unroll
        for (int e = 0; e < 8; ++e) { lhi[e] = (_Float16)lv[e]; llo[e] = (_Float16)(lv[e] - (float)lhi[e]); }
    }
    const float kmx = __uint_as_float(__hip_atomic_load((unsigned*)(F.ws + WS_CTL) + CW_KMAX + 64 * b, __ATOMIC_RELAXED, __HIP_MEMORY_SCOPE_AGENT));
    const float R = fmaxf(1.01f * rsum * sqrtf(kmx), 1e-30f);
    const float scale = 65534.0f / (2.0f * R), boff = R * scale;
    const int ntile = L / 16;
    const u16* kbase = KI + (size_t)(b * SEQ) * 32 + (size_t)j * 32 + 8 * fq;
    LAS unsigned char* myrow = lds + j * TK_ROW;
    {
        f16x8 cur[4], nxt[4];
#pragma unroll
        for (int u = 0; u < 4; ++u) { const int kt = wave + 8 * u; cur[u] = *(const f16x8*)(kbase + (size_t)(kt < ntile ? kt : 0) * 512); }
#pragma unroll 1
        for (int base = wave; base < ntile; base += 32) {
#pragma unroll
            for (int u = 0; u < 4; ++u) { const int kt = base + 32 + 8 * u; nxt[u] = *(const f16x8*)(kbase + (size_t)(kt < ntile ? kt : 0) * 512); }
            {
                f32x4 dA[9], dB[9]; float sc[4];
                tk_mfma(dA, cur[0], qf, lhi, llo); tk_mfma(dB, cur[1], qf, lhi, llo);
#define TK_P1(DD, U) do { tk_reduce(sc, DD, w2); const int kt = base + 8 * (U); \
                    const unsigned k0 = tk_key(sc[0], scale, boff), k1 = tk_key(sc[1], scale, boff), k2 = tk_key(sc[2], scale, boff), k3 = tk_key(sc[3], scale, boff); \
                    if (kt < ntile) *(LAS u32x2*)(myrow + (((4 * kt + fq) ^ j) << 3)) = (u32x2){k0 | (k1 << 16), k2 | (k3 << 16)}; } while (0)
                TK_P1(dA, 0); tk_mfma(dA, cur[2], qf, lhi, llo); TK_P1(dB, 1); tk_mfma(dB, cur[3], qf, lhi, llo); TK_P1(dA, 2); TK_P1(dB, 3);
#undef TK_P1
            }
#pragma unroll
            for (int u = 0; u < 4; ++u) cur[u] = nxt[u];
        }
    }
    __syncthreads();
    {
        const int q = 2 * wave; LAS unsigned char* rowb = lds + q * TK_ROW; unsigned* grow = gmask + (size_t)(t0 + q) * 128;
        int lane_ = lane; asm volatile("" : "+v"(lane_));
        LAS unsigned* hist = (LAS unsigned*)(lds + TK_HIST8 + wave * 2048);
        if (L <= 2048) tk_select2<16>(rowb, hist, q, L, lane_, grow); else tk_select2<32>(rowb, hist, q, L, lane_, grow);
    }
}
__device__ __forceinline__ void topk_phase(Frame& F) {
    unsigned* ctl = (unsigned*)(F.ws + WS_CTL);
    const int b0 = (F.vcu * 8) / F.G;
    BATCH_QUEUE_LOOP(F, ctl + CW_Q, 256, b0, b, u, topk_unit(F, b, 255 - u));
}

constexpr int PL_U = 0, PL_P = 20480, PL_S = PL_P + 16384, PL_END = PL_S + 16384;
template <int W>
__device__ __forceinline__ void pool_item(Frame& F, int tile, int g, const f16x8 (&bfr)[8], float ps) {
    const u16* UB = (const u16*)(F.ws + WS_UB); const u16* ZB = (const u16*)(F.ws + WS_ZB); u16* ZD = (u16*)(F.ws + WS_ZB);
    LAS unsigned char* lds = F.lds;
    const int tid = F.tid, lane = F.lane, r32 = lane & 31, hi = lane >> 5, wave = F.wave, th = wave >> 2, dblk = wave & 3;
    const int t0 = tile * 64, pos0 = t0 & (SEQ - 1);
    u32x4 zpre[2];
#pragma unroll
    for (int k = 0; k < 2; ++k) { const int e = tid + 512 * k; zpre[k] = *(const u32x4*)(ZB + (size_t)(t0 + (e >> 4)) * 512 + g * 128 + (e & 15) * 8); }
#pragma unroll
    for (int k = 0; k < 2; ++k) { const int e = tid + 512 * k, t = e >> 4, ch = e & 15;
        float sum[8];
#pragma unroll
        for (int x = 0; x < 8; ++x) sum[x] = 0.f;
#pragma unroll
        for (int i = 0; i < W; ++i) { const f16x8 v = *(const LAS f16x8*)(lds + PL_U + (t + W - 1 - i) * 256 + ch * 16);
#pragma unroll
            for (int x = 0; x < 8; ++x) sum[x] += (float)v[x]; }
        const f16x8 cur = *(const LAS f16x8*)(lds + PL_U + (t + W - 1) * 256 + ch * 16);
        const int pos = pos0 + t; const float rc = 1.0f / (float)((pos + 1 < W) ? pos + 1 : W);
        f16x8 pv;
#pragma unroll
        for (int x = 0; x < 8; ++x) pv[x] = (_Float16)(sum[x] * rc - (float)cur[x]);
        *(LAS f16x8*)(lds + PL_P + t * 256 + ((ch ^ (t & 15)) * 16)) = pv; }
    __syncthreads();
    f32x16 acc = {};
#pragma unroll
    for (int ks = 0; ks < 8; ++ks) { const f16x8 afr = *(const LAS f16x8*)(lds + PL_P + (32 * th + r32) * 256 + (((2 * ks + hi) ^ (r32 & 15)) * 16));
        acc = __builtin_amdgcn_mfma_f32_32x32x16_f16(afr, bfr[ks], acc, 0, 0, 0); }
#pragma unroll
    for (int r = 0; r < 16; ++r) { const int row = 32 * th + (r & 3) + 8 * (r >> 2) + 4 * hi; *(LAS _Float16*)(lds + PL_S + row * 256 + (32 * dblk + r32) * 2) = (_Float16)(acc[r] * ps); }
    __syncthreads();
#pragma unroll
    for (int k = 0; k < 2; ++k) { const int e = tid + 512 * k, row = e >> 4, ch = e & 15;
        const u32x4 a = *(const LAS u32x4*)(lds + PL_S + row * 256 + ch * 16); const size_t off = (size_t)(t0 + row) * 512 + g * 128 + ch * 8; const u32x4 z = zpre[k];
        u32x4 w; w.x = pk_f16(f16lo(a.x) * f16lo(z.x), f16hi(a.x) * f16hi(z.x)); w.y = pk_f16(f16lo(a.y) * f16lo(z.y), f16hi(a.y) * f16hi(z.y));
        w.z = pk_f16(f16lo(a.z) * f16lo(z.z), f16hi(a.z) * f16hi(z.z)); w.w = pk_f16(f16lo(a.w) * f16lo(z.w), f16hi(a.w) * f16hi(z.w));
        *(u32x4*)(ZD + off) = w; }
}
__device__ __forceinline__ void pool_fetch(Frame& F, int tile, int g, u32x4 (&pre)[3]) {
    const u16* UB = (const u16*)(F.ws + WS_UB); const int W = 2 << g, NR = 64 + W - 1, t0 = tile * 64, pos0 = t0 & (SEQ - 1);
#pragma unroll
    for (int k = 0; k < 3; ++k) { const int idx = F.tid + 512 * k, ur = idx >> 4, ch = idx & 15; pre[k] = (u32x4){0u, 0u, 0u, 0u};
        if (idx < NR * 16 && pos0 - (W - 1) + ur >= 0) pre[k] = *(const u32x4*)(UB + (size_t)(t0 - (W - 1) + ur) * 512 + g * 128 + ch * 8); }
}
__device__ __forceinline__ void pool_phase(Frame& F) {
    const u16* PW = (const u16*)(F.ws + WS_POOL);
    const int lane = F.lane, r32 = lane & 31, hi = lane >> 5, dblk = F.wave & 3;
    int gcur = -1; f16x8 bfr[8]; float ps = 0.f;
#pragma unroll
    for (int ks = 0; ks < 8; ++ks) bfr[ks] = f16x8{};
    const int NI = (M / 64) * 4; const bool rot = (F.G & 3) == 0;
    u32x4 pre[3];
    if (F.vcu < NI) pool_fetch(F, F.vcu >> 2, rot ? (F.vcu & 3) : (F.vcu & 3), pre);
#pragma unroll 1
    for (int k = 0, item = F.vcu; item < NI; ++k, item += F.G) {
        const int tile = item >> 2, g = rot ? ((item + k) & 3) : (item & 3), W = 2 << g, NR = 64 + W - 1;
        __syncthreads();
#pragma unroll
        for (int j = 0; j < 3; ++j) { const int idx = F.tid + 512 * j; if (idx < NR * 16) *(LAS u32x4*)(F.lds + PL_U + (idx >> 4) * 256 + (idx & 15) * 16) = pre[j]; }
        if (g != gcur) { gcur = g;
#pragma unroll
            for (int ks = 0; ks < 8; ++ks) bfr[ks] = *(const f16x8*)(PW + (size_t)g * 16384 + (size_t)(32 * dblk + r32) * 128 + 16 * ks + 8 * hi);
            ps = F.pool_scale[g * 128 + 32 * dblk + r32]; }
        __syncthreads();
        { const int nitem = item + F.G; if (nitem < NI) pool_fetch(F, nitem >> 2, rot ? ((nitem + k + 1) & 3) : (nitem & 3), pre); }
        if (g == 0) pool_item<2>(F, tile, g, bfr, ps); else if (g == 1) pool_item<4>(F, tile, g, bfr, ps); else if (g == 2) pool_item<8>(F, tile, g, bfr, ps); else pool_item<16>(F, tile, g, bfr, ps);
    }
    __syncthreads();
}

namespace at2 {
typedef LAS const unsigned char* lds_cptr;
constexpr int NSLOT = 3, SLOTB = 8192;
constexpr int LDS_K = 0, LDS_V = NSLOT * SLOTB, LDS_M = 2 * NSLOT * SLOTB, LDS_WS = LDS_M + 32768, LDS_OST = LDS_WS + 2048, LDS_END = LDS_OST + 8 * 4096;
static_assert(LDS_END <= RING_BYTES, "attention LDS map");
#define SBAR() __builtin_amdgcn_sched_barrier(0)
#define WAIT_BAR(N) asm volatile("s_waitcnt vmcnt(" #N ") lgkmcnt(0)\n\ts_barrier" ::: "memory")
__device__ __forceinline__ void glds16(const void* gsrc, unsigned lds_dst) { unsigned keep;
    asm volatile("s_mov_b32 %0, m0\n\ts_mov_b32 m0, %2\n\ts_nop 0\n\tglobal_load_lds_dwordx4 %1, off\n\ts_mov_b32 m0, %0" : "=&s"(keep) : "v"(gsrc), "s"(lds_dst) : "memory"); }
__device__ __forceinline__ void kload8(s16x8* kf, lds_cptr kp) {
    kf[0] = *(const LAS s16x8*)(kp);        kf[1] = *(const LAS s16x8*)(kp + 512);
    kf[2] = *(const LAS s16x8*)(kp + 2048); kf[3] = *(const LAS s16x8*)(kp + 2560);
    kf[4] = *(const LAS s16x8*)(kp + 4096); kf[5] = *(const LAS s16x8*)(kp + 4608);
    kf[6] = *(const LAS s16x8*)(kp + 6144); kf[7] = *(const LAS s16x8*)(kp + 6656); }
__device__ __forceinline__ void kload2(s16x8* kf, lds_cptr kp, int j) { kf[2 * j] = *(const LAS s16x8*)(kp + j * 2048); kf[2 * j + 1] = *(const LAS s16x8*)(kp + j * 2048 + 512); }
__device__ __forceinline__ s16x4 vtr(lds_cptr p) { return __builtin_bit_cast(s16x4, __builtin_amdgcn_ds_read_tr16_b64_v4i16((LAS s16x4*)p)); }
__device__ __forceinline__ float mexp(float x, unsigned w, int bp) { return __uint_as_float(__float_as_uint(__builtin_amdgcn_exp2f(x)) & (unsigned)__builtin_amdgcn_sbfe((int)w, (unsigned)bp, 1u)); }
__device__ __forceinline__ void pv_drain(f32x16* o, lds_cptr vp, s16x8 pa0, s16x8 pa1, s16x8 pa2, s16x8 pa3) {
#pragma unroll
    for (int d0 = 0; d0 < 2; ++d0) { s16x4 lo[4], hh[4];
#pragma unroll
        for (int ks = 0; ks < 4; ++ks) { lo[ks] = vtr(vp + d0 * 4096 + ks * 1024); hh[ks] = vtr(vp + d0 * 4096 + ks * 1024 + 512); }
#define PK(k) (s16x8){lo[k][0], lo[k][1], lo[k][2], lo[k][3], hh[k][0], hh[k][1], hh[k][2], hh[k][3]}
        o[d0] = __builtin_amdgcn_mfma_f32_32x32x16_bf16(pa0, PK(0), o[d0], 0, 0, 0);
        o[d0] = __builtin_amdgcn_mfma_f32_32x32x16_bf16(pa1, PK(1), o[d0], 0, 0, 0);
        o[d0] = __builtin_amdgcn_mfma_f32_32x32x16_bf16(pa2, PK(2), o[d0], 0, 0, 0);
        o[d0] = __builtin_amdgcn_mfma_f32_32x32x16_bf16(pa3, PK(3), o[d0], 0, 0, 0);
#undef PK
    }
}
__device__ __forceinline__ void attn_unit(Frame& F, int b, int g, int c) {
    const int lane = F.lane, r32 = lane & 31, hi = lane >> 5, wid = F.wave;
    const u16* QB = (const u16*)(F.ws + WS_QB); const u16* KB = (const u16*)(F.ws + WS_KB); const u16* VB = (const u16*)(F.ws + WS_VB);
    const unsigned* gmask = (const unsigned*)(F.ws + WS_MASK); u16* ZA = (u16*)(F.ws + WS_ZA); u16* ZD = ZA;
    const int head = 4 * g + (wid >> 1), qrow0 = b * SEQ + 64 * c + 32 * (wid & 1);
    const int NT = c + 1;
    lds_cptr shm = (lds_cptr)F.lds; const unsigned lds0 = (unsigned)(size_t)F.lds;
    const u16* Kh = KB + (size_t)(b * SEQ) * 128 + g * 64; const u16* Vh = VB + (size_t)(b * SEQ) * 128 + g * 64;
    const u16* ksrc = Kh + (size_t)lane * 128 + wid * 8;
    const u16* vsrc = Vh + (size_t)(16 * (wid & 3) + (lane >> 2)) * 128 + (wid >> 2) * 32 + (lane & 3) * 8;
    const unsigned kdst = lds0 + LDS_K + wid * 1024, vdst = lds0 + LDS_V + wid * 1024;
#define TC(t) (((t) < NT) ? (t) : (NT - 1))
#define DMA_K(t, slot) glds16(ksrc + (size_t)TC(t) * 64 * 128, (unsigned)__builtin_amdgcn_readfirstlane(kdst + (slot)))
#define DMA_V(t, slot) glds16(vsrc + (size_t)TC(t) * 64 * 128, (unsigned)__builtin_amdgcn_readfirstlane(vdst + (slot)))
    const lds_cptr kp0 = shm + LDS_K + hi * 1024 + r32 * 16;
    const lds_cptr vp0 = shm + LDS_V + ((lane >> 4) & 1) * 32 + (lane & 3) * 8 + (4 * hi + ((lane & 15) >> 2)) * 64;
    const lds_cptr mp0 = shm + LDS_M + (32 * (wid & 1) + r32) * 16;
    for (int ch = wid; ch < (NT + 1) / 2; ch += 8) glds16(gmask + (size_t)(b * SEQ + 64 * c + lane) * 128 + ch * 4, (unsigned)__builtin_amdgcn_readfirstlane(lds0 + LDS_M + ch * 1024));
    DMA_K(0, 0); DMA_V(0, 0); DMA_K(1, SLOTB);
    s16x8 qr[4];
#pragma unroll
    for (int d0 = 0; d0 < 4; ++d0) qr[d0] = *(const s16x8*)(QB + (size_t)(qrow0 + r32) * 512 + head * 64 + d0 * 16 + hi * 8);
    float l_reg = 0.f; f32x16 o[2]; o[0] = f32x16{}; o[1] = f32x16{};
    const f32x16 zero16 = f32x16{};
    f32x16 pA0, pA1, pB0, pB1;
    int sl_prev = 0, sl_cur = 0, sl_next = SLOTB;
#define ROT() do { sl_prev = sl_cur; sl_cur = sl_next; sl_next = (sl_next == (NSLOT - 1) * SLOTB) ? 0 : sl_next + SLOTB; } while (0)
    DMA_K(2, 2 * SLOTB);
    WAIT_BAR(3);
    {
        const lds_cptr kb = kp0;
#pragma unroll
        for (int d0 = 0; d0 < 4; ++d0) {
            const s16x8 b0 = *(const LAS s16x8*)(kb + d0 * 2048), b1 = *(const LAS s16x8*)(kb + d0 * 2048 + 512);
            if (d0 == 0) { pA0 = __builtin_amdgcn_mfma_f32_32x32x16_bf16(b0, qr[0], zero16, 0, 0, 0); pA1 = __builtin_amdgcn_mfma_f32_32x32x16_bf16(b1, qr[0], zero16, 0, 0, 0); }
            else { pA0 = __builtin_amdgcn_mfma_f32_32x32x16_bf16(b0, qr[d0], pA0, 0, 0, 0); pA1 = __builtin_amdgcn_mfma_f32_32x32x16_bf16(b1, qr[d0], pA1, 0, 0, 0); } }
        const u32x2 mw = *(const LAS u32x2*)(mp0); const unsigned w0 = mw.x >> (4 * hi), w1 = mw.y >> (4 * hi);
#pragma unroll
        for (int r = 0; r < 16; ++r) { const int bp = (r & 3) + 8 * (r >> 2); pA0[r] = mexp(pA0[r], w0, bp); pA1[r] = mexp(pA1[r], w1, bp); }
    }
    WAIT_BAR(0);
    DMA_K(3, 0); DMA_V(1, SLOTB);
    ROT();
    s16x8 kf[8];
    kload8(kf, kp0 + sl_cur);
    WAIT_BAR(2);
    s16x4 vlo[8], vhi[8]; u32x4 pw0, pw1, pw2, pw3;
#define PKW(P, B) pk_bf16(P[B], P[B + 1])
#define PAF(k) __builtin_bit_cast(s16x8, pw##k)
#define VFR(i) (s16x8){vlo[i][0], vlo[i][1], vlo[i][2], vlo[i][3], vhi[i][0], vhi[i][1], vhi[i][2], vhi[i][3]}
#define PIN(x) asm volatile("" : "+v"(x))
#define GAPA(MF, A0, A1, A2, A3, W0, W1, PW, G) do { MF; sacc += A0; sacc += A1; sacc += A2; sacc += A3; PIN(sacc); W0; W1; PIN(PW); \
        mk0[2 * (G)] = (unsigned)__builtin_amdgcn_sbfe((int)w0_, (unsigned)(((2 * (G)) & 3) + 8 * ((2 * (G)) >> 2)), 1u); mk0[2 * (G) + 1] = (unsigned)__builtin_amdgcn_sbfe((int)w0_, (unsigned)(((2 * (G) + 1) & 3) + 8 * ((2 * (G) + 1) >> 2)), 1u); PIN(mk0[2 * (G)]); PIN(mk0[2 * (G) + 1]); SBAR(); } while (0)
#define GAPB(MF, X, B, W) do { MF; X[B] = mexp(X[B], W, 2 * (B)); X[B + 1] = mexp(X[B + 1], W, 2 * (B) + 1); X[B + 2] = mexp(X[B + 2], W, 2 * (B) + 2); X[B + 3] = mexp(X[B + 3], W, 2 * (B) + 3); PIN(X); SBAR(); } while (0)
#define MEXP0(x, m) __uint_as_float(__float_as_uint(__builtin_amdgcn_exp2f(x)) & (m))
#define GAPB0(MF, X, B) do { MF; X[B] = MEXP0(X[B], mk0[B]); X[B + 1] = MEXP0(X[B + 1], mk0[B + 1]); X[B + 2] = MEXP0(X[B + 2], mk0[B + 2]); X[B + 3] = MEXP0(X[B + 3], mk0[B + 3]); PIN(X); SBAR(); } while (0)
#define VRD(i) do { vlo[i] = vtr(vp_ + (((i) >> 2) * 4096 + ((i) & 3) * 1024)); vhi[i] = vtr(vp_ + (((i) >> 2) * 4096 + ((i) & 3) * 1024 + 512)); } while (0)
#define KRD(j) do { kload2(kf, kp0 + sl_next, j); SBAR(); } while (0)
#define STEP(C0, C1, P0, P1, t) do { SBAR(); \
    const lds_cptr vp_ = vp0 + sl_prev; \
    const u32x2 mw_ = *(const LAS u32x2*)(mp0 + ((t) >> 1) * 1024 + ((t) & 1) * 8); const unsigned w0_ = mw_.x >> (4 * hi), w1_ = mw_.y >> (4 * hi); \
    unsigned mk0[16]; VRD(0); SBAR(); float sacc = (P0[0] + P0[1]); \
    GAPA(C0 = __builtin_amdgcn_mfma_f32_32x32x16_bf16(kf[0], qr[0], zero16, 0, 0, 0), P0[2], P0[3], P0[4], P0[5],     pw0[0] = PKW(P0, 0), pw0[1] = PKW(P0, 2), pw0, 0); \
    VRD(4); SBAR(); GAPA(C1 = __builtin_amdgcn_mfma_f32_32x32x16_bf16(kf[1], qr[0], zero16, 0, 0, 0), P0[6], P0[7], P0[8], P0[9],     pw0[2] = PKW(P0, 4), pw0[3] = PKW(P0, 6), pw0, 1); \
    VRD(1); SBAR(); GAPA(C0 = __builtin_amdgcn_mfma_f32_32x32x16_bf16(kf[2], qr[1], C0, 0, 0, 0),   P0[10], P0[11], P0[12], P0[13], pw1[0] = PKW(P0, 8), pw1[1] = PKW(P0, 10), pw1, 2); \
    VRD(5); SBAR(); GAPA(C1 = __builtin_amdgcn_mfma_f32_32x32x16_bf16(kf[3], qr[1], C1, 0, 0, 0),   P0[14], P0[15], P1[0], P1[1],   pw1[2] = PKW(P0, 12), pw1[3] = PKW(P0, 14), pw1, 3); \
    VRD(2); SBAR(); GAPA(C0 = __builtin_amdgcn_mfma_f32_32x32x16_bf16(kf[4], qr[2], C0, 0, 0, 0),   P1[2], P1[3], P1[4], P1[5],     pw2[0] = PKW(P1, 0), pw2[1] = PKW(P1, 2), pw2, 4); \
    VRD(6); SBAR(); GAPA(C1 = __builtin_amdgcn_mfma_f32_32x32x16_bf16(kf[5], qr[2], C1, 0, 0, 0),   P1[6], P1[7], P1[8], P1[9],     pw2[2] = PKW(P1, 4), pw2[3] = PKW(P1, 6), pw2, 5); \
    VRD(3); SBAR(); GAPA(C0 = __builtin_amdgcn_mfma_f32_32x32x16_bf16(kf[6], qr[3], C0, 0, 0, 0),   P1[10], P1[11], P1[12], P1[13], pw3[0] = PKW(P1, 8), pw3[1] = PKW(P1, 10), pw3, 6); \
    VRD(7); SBAR(); GAPA(C1 = __builtin_amdgcn_mfma_f32_32x32x16_bf16(kf[7], qr[3], C1, 0, 0, 0),   P1[14], P1[15], 0.f, 0.f,       pw3[2] = PKW(P1, 12), pw3[3] = PKW(P1, 14), pw3, 7); \
    l_reg += sacc; \
    DMA_K((t) + 3, sl_cur); DMA_V((t) + 1, sl_next); \
    SBAR(); \
    GAPB0(o[0] = __builtin_amdgcn_mfma_f32_32x32x16_bf16(PAF(0), VFR(0), o[0], 0, 0, 0), C0, 0); \
    GAPB0(o[1] = __builtin_amdgcn_mfma_f32_32x32x16_bf16(PAF(0), VFR(4), o[1], 0, 0, 0), C0, 4); \
    KRD(0); GAPB0(o[0] = __builtin_amdgcn_mfma_f32_32x32x16_bf16(PAF(1), VFR(1), o[0], 0, 0, 0), C0, 8); \
    KRD(1); GAPB0(o[1] = __builtin_amdgcn_mfma_f32_32x32x16_bf16(PAF(1), VFR(5), o[1], 0, 0, 0), C0, 12); \
    KRD(2); GAPB(o[0] = __builtin_amdgcn_mfma_f32_32x32x16_bf16(PAF(2), VFR(2), o[0], 0, 0, 0), C1, 0, w1_); \
    KRD(3); GAPB(o[1] = __builtin_amdgcn_mfma_f32_32x32x16_bf16(PAF(2), VFR(6), o[1], 0, 0, 0), C1, 4, w1_); \
    GAPB(o[0] = __builtin_amdgcn_mfma_f32_32x32x16_bf16(PAF(3), VFR(3), o[0], 0, 0, 0), C1, 8, w1_); \
    GAPB(o[1] = __builtin_amdgcn_mfma_f32_32x32x16_bf16(PAF(3), VFR(7), o[1], 0, 0, 0), C1, 12, w1_); \
    } while (0)
#define DRAIN(P0, P1) do { float sacc = 0.f; _Pragma("unroll") for (int r = 0; r < 16; ++r) sacc += P0[r] + P1[r]; l_reg += sacc; \
    pw0 = (u32x4){PKW(P0, 0), PKW(P0, 2), PKW(P0, 4), PKW(P0, 6)}; pw1 = (u32x4){PKW(P0, 8), PKW(P0, 10), PKW(P0, 12), PKW(P0, 14)}; \
    pw2 = (u32x4){PKW(P1, 0), PKW(P1, 2), PKW(P1, 4), PKW(P1, 6)}; pw3 = (u32x4){PKW(P1, 8), PKW(P1, 10), PKW(P1, 12), PKW(P1, 14)}; \
    SBAR(); pv_drain(o, vp0 + sl_prev, PAF(0), PAF(1), PAF(2), PAF(3)); } while (0)
    int t = 1;
#pragma unroll 1
    for (; t + 1 < NT; t += 2) {
        STEP(pB0, pB1, pA0, pA1, t);     WAIT_BAR(2); ROT();
        STEP(pA0, pA1, pB0, pB1, t + 1); WAIT_BAR(2); ROT();
    }
    u32x4 zpre[4];
#define ZA_PRE() do { _Pragma("unroll") for (int i = 0; i < 4; ++i) zpre[i] = *(const u32x4*)(ZA + (size_t)(qrow0 + i * 8 + (lane >> 3)) * 512 + head * 64 + (lane & 7) * 8); } while (0)
    if (t < NT) { STEP(pB0, pB1, pA0, pA1, t); WAIT_BAR(2); ROT(); ZA_PRE(); DRAIN(pB0, pB1); }
    else { ZA_PRE(); DRAIN(pA0, pA1); }
#undef ZA_PRE
    { auto rr = __builtin_amdgcn_permlane32_swap(__float_as_uint(l_reg), __float_as_uint(l_reg), false, false); l_reg = __uint_as_float(rr[0]) + __uint_as_float(rr[1]); }
    LAS float* wsf = (LAS float*)(F.lds + LDS_WS) + wid * 64;
    if (hi == 0) wsf[r32] = l_reg;
    asm volatile("s_waitcnt lgkmcnt(0)" ::: "memory");
    float rli[16];
#pragma unroll
    for (int r = 0; r < 16; ++r) rli[r] = __builtin_amdgcn_rcpf(wsf[(r & 3) + 8 * (r >> 2) + 4 * hi]);
    LAS _Float16* stg = (LAS _Float16*)(F.lds + LDS_OST) + wid * 2048;
#pragma unroll
    for (int r = 0; r < 16; ++r) { const int orow = (r & 3) + 8 * (r >> 2) + 4 * hi;
#pragma unroll
        for (int d0 = 0; d0 < 2; ++d0) stg[orow * 64 + d0 * 32 + r32] = (_Float16)(o[d0][r] * rli[r]); }
    asm volatile("s_waitcnt lgkmcnt(0)" ::: "memory");
#pragma unroll
    for (int i = 0; i < 4; ++i) { const int row = i * 8 + (lane >> 3), ch = lane & 7;
        const u32x4 a = *(const LAS u32x4*)(stg + row * 64 + ch * 8);
        const u32x4 z = zpre[i];
        u32x4 w; w.x = pk_f16(f16lo(a.x) * f16lo(z.x), f16hi(a.x) * f16hi(z.x)); w.y = pk_f16(f16lo(a.y) * f16lo(z.y), f16hi(a.y) * f16hi(z.y));
        w.z = pk_f16(f16lo(a.z) * f16lo(z.z), f16hi(a.z) * f16hi(z.z)); w.w = pk_f16(f16lo(a.w) * f16lo(z.w), f16hi(a.w) * f16hi(z.w));
        *(u32x4*)(ZD + (size_t)(qrow0 + row) * 512 + head * 64 + ch * 8) = w; }
    asm volatile("s_waitcnt vmcnt(0) lgkmcnt(0)\n\ts_barrier" ::: "memory");
#undef TC
#undef DMA_K
#undef DMA_V
#undef ROT
#undef PKW
#undef PAF
#undef VFR
#undef PIN
#undef GAPA
#undef GAPB
#undef GAPB0
#undef MEXP0
#undef VRD
#undef KRD
#undef STEP
#undef DRAIN
}
#undef SBAR
#undef WAIT_BAR
}
__device__ __forceinline__ void attn_phase(Frame& F) {
    unsigned* ctl = (unsigned*)(F.ws + WS_CTL);
    if (F.G == 256) {
        const int b = F.vcu >> 5, jj = F.vcu & 31, g = jj >> 4, s_ = jj & 15;
#pragma unroll 1
        for (int i = 0; i < 4; ++i) { const int c = (i == 0) ? 63 - s_ : (i == 1) ? 32 + s_ : (i == 2) ? 31 - s_ : s_; at2::attn_unit(F, b, g, c); }
        __syncthreads();
    } else {
        const int b0 = (F.vcu * 8) / F.G;
        BATCH_QUEUE_LOOP(F, ctl + CW_Q + 16 * 8, 128, b0, b, u, at2::attn_unit(F, b, u & 1, 63 - (u >> 1)));
    }
}

struct Args { const void* in[12]; float* out; unsigned char* ws; int ph_lo, ph_hi, li, pad; };
constexpr int N_PHASES = 6;
__global__ void __launch_bounds__(512, 2) fwd_kernel(Args args) {
    extern __shared__ __attribute__((aligned(16))) unsigned char lds_raw[];
    Frame F;
    F.lds = (LAS unsigned char*)lds_raw;
    F.tid = threadIdx.x; F.lane = F.tid & 63; F.wave = __builtin_amdgcn_readfirstlane(F.tid >> 6);
    F.G = gridDim.x; { const int bx = blockIdx.x; F.vcu = (F.G % 8 == 0) ? (bx % 8) * (F.G / 8) + bx / 8 : bx; }
    F.x = (const float*)args.in[0]; F.pos = (const int*)args.in[1]; F.norm_g = (const float*)args.in[2]; F.w_in = (const float*)args.in[3]; F.mbias = (const float*)args.in[4];
    F.qng = (const float*)args.in[5]; F.kng = (const float*)args.in[6]; F.pool_w = (const float*)args.in[7]; F.pool_scale = (const float*)args.in[8];
    F.wba = (const float*)args.in[9]; F.wbb = (const float*)args.in[10]; F.wout = (const float*)args.in[11];
    F.out = args.out; F.ws = args.ws;
    unsigned* ctl = (unsigned*)(F.ws + WS_CTL);
    volatile LAS unsigned* MISC = (volatile LAS unsigned*)(F.lds + MISC_OFF);
    for (int u = F.tid; u < (LDS_BYTES - LDSCTL_OFF) / 4; u += 512) ((LAS unsigned*)(F.lds + LDSCTL_OFF))[u] = 0u;
    __syncthreads();
    XcdBarrier bar; bar.bar = ctl + CW_BAR; bar.x = 0; bar.st = nullptr;
    if (MK_N_LAUNCHES == 1) bar = xcd_barrier_post(ctl + CW_BAR, MISC + 8);
    const int lo = args.ph_lo, hi = args.ph_hi;
#define IN(k) (lo <= (k) && (k) < hi)
#define SEAM(k) do { if (IN(k) && IN((k) + 1)) xcd_barrier(bar); } while (0)
    if (IN(0)) { p0_prologue(F); SEAM(0); }
    if (IN(1)) {
        pg8::Gemm g{(const u16*)(F.ws + WS_XH), (const u16*)(F.ws + WS_WIN), M, NPAD, DM}; pg8::InProjOrder S{F.G, (int)blockIdx.x};
        EpiIn E{(const float*)(F.ws + WS_RSTD), (const float*)(F.ws + WS_ROPEA), (const float*)(F.ws + WS_ROPEI), F.qng, F.kng, F.mbias,
                (u16*)(F.ws + WS_QB), (u16*)(F.ws + WS_KB), (u16*)(F.ws + WS_VB), (u16*)(F.ws + WS_QI), (u16*)(F.ws + WS_KI), (u16*)(F.ws + WS_ZA), (u16*)(F.ws + WS_UB), (u16*)(F.ws + WS_ZB), (u16*)(F.ws + WS_GT),
                (float*)(F.ws + WS_WI), ctl + CW_KMAX};
        pg8::gemm_phase<EpiIn, pg8::InProjOrder, 18>(F.lds, g, S, E);
        SEAM(1);
    }
    if (IN(2)) { topk_phase(F); pool_phase(F); SEAM(2); }
    if (IN(3)) { attn_phase(F); SEAM(3); }
    if (IN(4)) {
        pg8::Gemm g{(const u16*)(F.ws + WS_ZA), (const u16*)(F.ws + WS_WAB), 2 * M, 2048, 512}; pg8::PairOrder S{F.G, (int)blockIdx.x};
        EpiBranch E{(const u16*)(F.ws + WS_GT), (u16*)(F.ws + WS_Y)};
        pg8::gemm_phase<EpiBranch, pg8::PairOrder>(F.lds, g, S, E);
        SEAM(4);
    }
    if (IN(5)) {
        pg8::Gemm g{(const u16*)(F.ws + WS_Y), (const u16*)(F.ws + WS_WOUT), M, DM, DM}; pg8::StaticOrder S; S.init(M, DM, F.G, (int)blockIdx.x);
        EpiOut E{(const u16*)(F.ws + WS_XH), F.out};
        pg8::gemm_phase<EpiOut, pg8::StaticOrder>(F.lds, g, S, E);
    }
#undef IN
#undef SEAM
}

extern "C" void kernel_launch(void* const* d_in, const int* in_sizes, int n_in, void* d_out, int out_size, void* d_ws, size_t ws_size, hipStream_t stream) {
    static int grid = 0;
    if (grid == 0) {
        if (n_in != 12 || out_size != M * DM || ws_size < WS_END) { fprintf(stderr, "kernel_launch: unexpected shapes (n_in %d out %d ws %zu)\n", n_in, out_size, ws_size); grid = -1; return; }
        int dev = 0, cus = 0, per_cu = 0;
        if (hipGetDevice(&dev) != hipSuccess || hipDeviceGetAttribute(&cus, hipDeviceAttributeMultiprocessorCount, dev) != hipSuccess) { grid = -1; return; }
        if (hipFuncSetAttribute((const void*)fwd_kernel, hipFuncAttributeMaxDynamicSharedMemorySize, LDS_BYTES) != hipSuccess) { fprintf(stderr, "kernel_launch: hipFuncSetAttribute failed\n"); grid = -1; return; }
        if (hipOccupancyMaxActiveBlocksPerMultiprocessor(&per_cu, (const void*)fwd_kernel, 512, LDS_BYTES) != hipSuccess || per_cu < 1) { fprintf(stderr, "kernel_launch: occupancy query says %d\n", per_cu); (void)hipGetLastError(); grid = -1; return; }
        grid = cus;
        if (grid > 256) grid = 256;
    }
    if (grid < 0) return;
    (void)hipMemsetAsync((char*)d_ws + WS_CTL, 0, CTL_ZERO_BYTES, stream);
    Args a{};
    for (int i = 0; i < 12; ++i) a.in[i] = d_in[i];
    a.out = (float*)d_out; a.ws = (unsigned char*)d_ws;
    if (MK_N_LAUNCHES == 1) {
        a.ph_lo = 0; a.ph_hi = N_PHASES; a.li = 0;
        void* kargs[] = {&a};
        hipError_t e = hipLaunchCooperativeKernel((const void*)fwd_kernel, dim3(grid), dim3(512), kargs, LDS_BYTES, stream);
        if (e != hipSuccess) fprintf(stderr, "kernel_launch: cooperative launch failed: %s\n", hipGetErrorString(e));
    } else {
        for (int li = 0; li < N_PHASES; ++li) { a.ph_lo = li; a.ph_hi = li + 1; a.li = li; hipLaunchKernelGGL(fwd_kernel, dim3(grid), dim3(512), LDS_BYTES, stream, a); }
    }
}
```

```cpp
#include <hip/hip_runtime.h>
#include <cstdio>
#include <cstdint>

#ifndef MK_N_LAUNCHES
#define MK_N_LAUNCHES 1
#endif

#define LAS __attribute__((address_space(3)))
#define GAS __attribute__((address_space(1)))
typedef unsigned short u16;
typedef _Float16 f16x8 __attribute__((ext_vector_type(8)));
typedef _Float16 f16x4 __attribute__((ext_vector_type(4)));
typedef _Float16 f16x2 __attribute__((ext_vector_type(2)));
typedef __bf16 bf16x2_t __attribute__((ext_vector_type(2)));
typedef short s16x8 __attribute__((ext_vector_type(8)));
typedef short s16x4 __attribute__((ext_vector_type(4)));
typedef float f32x2 __attribute__((ext_vector_type(2)));
typedef float f32x4 __attribute__((ext_vector_type(4)));
typedef float f32x16 __attribute__((ext_vector_type(16)));
typedef unsigned u32x2 __attribute__((ext_vector_type(2)));
typedef unsigned u32x4 __attribute__((ext_vector_type(4)));
typedef unsigned short us2 __attribute__((ext_vector_type(2)));

constexpr int BATCH = 8, SEQ = 4096, DM = 1024, M = BATCH * SEQ;
constexpr int DIN = 4648, NPAD = 4864;
constexpr float EPS = 1e-6f;
constexpr float C2 = 0.125f * 1.4426950408889634f;

__device__ __forceinline__ unsigned pk_f16(float a, float b) { f32x2 v = {a, b}; f16x2 h = __builtin_convertvector(v, f16x2); return __builtin_bit_cast(unsigned, h); }
__device__ __forceinline__ unsigned pk_bf16(float a, float b) { f32x2 v = {a, b}; bf16x2_t h = __builtin_convertvector(v, bf16x2_t); return __builtin_bit_cast(unsigned, h); }
__device__ __forceinline__ float f16lo(unsigned u) { f16x2 h = __builtin_bit_cast(f16x2, u); return (float)h.x; }
__device__ __forceinline__ float f16hi(unsigned u) { f16x2 h = __builtin_bit_cast(f16x2, u); return (float)h.y; }
__device__ __forceinline__ float silu_f(float x) { return x * __builtin_amdgcn_rcpf(1.0f + __expf(-x)); }
__device__ __forceinline__ float sigm_f(float x) { return __builtin_amdgcn_rcpf(1.0f + __expf(-x)); }

namespace pg8 {
constexpr int BM = 256, BK = 64, HALF = 128, HTB = HALF * BK * 2, STAGE_BYTES = 8 * HTB, NXCD = 8, WGM = 8;
__host__ __device__ __forceinline__ int lds_byte(int r, int c) { const int st = (r >> 4) * 2 + (c >> 5), rr = r & 15, cc = c & 31, ob = rr * 64 + cc * 2; return st * 1024 + (ob ^ (((ob >> 9) & 1) << 5)); }
__host__ __device__ __forceinline__ void stage_rc(int b, int& R, int& C) { const int st = b / 1024, sb = b % 1024, swz = sb ^ (((sb >> 9) & 1) << 5); R = (st >> 1) * 16 + swz / 64; C = (st & 1) * 32 + (swz % 64) / 2; }
__host__ __device__ __forceinline__ int perm32(int rho) { const int n = rho >> 4, i = rho & 15; return 8 * (i >> 2) + 4 * n + (i & 3); }
struct Unit { int pm, pn; };
struct Gemm { const u16* A; const u16* Bt; int M, N, K; };
__device__ __forceinline__ void map_tile(int wgid, int nM, int nN, int& pm, int& pn) {
    const int nwg = nM * nN;
    { const int q = nwg / NXCD, r = nwg % NXCD, xcd = wgid % NXCD, off = wgid / NXCD; wgid = (xcd < r ? xcd * (q + 1) : r * (q + 1) + (xcd - r) * q) + off; }
    const int nig = WGM * nN, gid = wgid / nig, fm = gid * WGM, gsz = (nM - fm) < WGM ? (nM - fm) : WGM;
    pm = fm + ((wgid % nig) % gsz); pn = (wgid % nig) / gsz;
}
struct StaticOrder {
    int nM, nN, nwg, G, c;
    __device__ void init(int M_, int N_, int G_, int c_) { nM = M_ / BM; nN = N_ / BM; nwg = nM * nN; G = G_; c = c_; }
    __device__ bool next(int i, Unit& u) const { const long L = (long)i * G + c; if (L >= nwg) return false; map_tile((int)L, nM, nN, u.pm, u.pn); return true; }
};
struct InProjOrder {
    int G, c;
    __device__ bool next(int i, Unit& u) const { const long L = (long)i * G + c; if (L >= 2432) return false;
        if (L < 2304) { map_tile((int)L, 128, 18, u.pm, u.pn); } else { const int j = (int)L - 2304; u.pm = (j & 7) * 16 + (j >> 3); u.pn = 18; } return true; }
};
struct PairOrder {
    int G, c;
    __device__ bool next(int i, Unit& u) const { const int part = i & 1; const long L = (long)(i >> 1) * G + c; if (L >= 512) return false; int pm, pn; map_tile((int)L, 128, 4, pm, pn); u.pm = pm + 128 * part; u.pn = pn + 4 * part; return true; }
};

template <class Epi, class Sched, int NARROW_PN = -1>
__device__ __forceinline__ void gemm_phase(LAS unsigned char* lds, const Gemm g, const Sched& S, const Epi& E) {
    const int tid = threadIdx.x, wid = __builtin_amdgcn_readfirstlane(tid >> 6), lane = tid & 63, wr = wid >> 2, wc = wid & 3, fr = lane & 15, fq = lane >> 4;
    const int K = g.K, nt = K / BK;
    unsigned voffA[2], voffB[2];
#pragma unroll
    for (int i = 0; i < 2; ++i) { int R, C; stage_rc(tid * 16 + i * 8192, R, C); const int Rb = (R & ~31) + perm32(R & 31);
        voffA[i] = (unsigned)(R * K + C) * 2u; voffB[i] = (unsigned)(Rb * K + C) * 2u; }
    const size_t kstep = (size_t)(BK * 2);
    const size_t hstep = (size_t)HALF * K * 2;
    const size_t tstep = 2 * hstep;
    const unsigned ldsw = (unsigned)wid * 1024u;
    const int aoff = lds_byte(wr * 64 + fr, fq * 8), boff = lds_byte(wc * 32 + fr, fq * 8);
#define PG8_SA(b, h) (((b) * 2 + (h)) * HTB)
#define PG8_SB(b, h) ((4 + (b) * 2 + (h)) * HTB)
#define PG8_STAGE(bufoff, gbase, voff) do { _Pragma("unroll") for (int _i = 0; _i < 2; ++_i) \
        __builtin_amdgcn_global_load_lds((const unsigned*)((const char*)(gbase) + (voff)[_i]), (LAS unsigned*)(lds + (bufoff) + ldsw + _i * 8192), 16, 0, 0); } while (0)
#define PG8_LDA(dst, b, h) do { _Pragma("unroll") for (int m = 0; m < 4; ++m) _Pragma("unroll") for (int k = 0; k < 2; ++k) dst[m][k] = *(const LAS f16x8*)(lds + PG8_SA(b, h) + aoff + m * 2048 + k * 1024); } while (0)
#define PG8_LDB(dst, b, h) do { _Pragma("unroll") for (int n = 0; n < 2; ++n) _Pragma("unroll") for (int k = 0; k < 2; ++k) dst[n][k] = *(const LAS f16x8*)(lds + PG8_SB(b, h) + boff + n * 2048 + k * 1024); } while (0)
#define PG8_MMA(ai, bj, At, Bt) do { __builtin_amdgcn_s_setprio(1); _Pragma("unroll") for (int m = 0; m < 4; ++m) _Pragma("unroll") for (int n = 0; n < 2; ++n) _Pragma("unroll") for (int k = 0; k < 2; ++k) \
        acc[ai][bj][m][n] = __builtin_amdgcn_mfma_f32_16x16x32_f16(Bt[n][k], At[m][k], acc[ai][bj][m][n], 0, 0, 0); __builtin_amdgcn_s_setprio(0); } while (0)
#define PG8_WAIT_V(n) asm volatile("s_waitcnt vmcnt(" #n ")" ::: "memory")
#define PG8_WAIT_L(n) asm volatile("s_waitcnt lgkmcnt(" #n ")" ::: "memory")
#define PG8_BAR __builtin_amdgcn_s_barrier()
#define PG8_SCHED __builtin_amdgcn_sched_barrier(0)
    Unit cur, nxt; int ui = 0;
    if (!S.next(0, cur)) return;
    f32x4 acc[2][2][4][2];
#pragma unroll
    for (int a = 0; a < 2; ++a)
#pragma unroll
        for (int b = 0; b < 2; ++b)
#pragma unroll
            for (int m = 0; m < 4; ++m)
#pragma unroll
                for (int n = 0; n < 2; ++n) acc[a][b][m][n] = (f32x4){0.f, 0.f, 0.f, 0.f};
    f16x8 At[4][2], B0[2][2], B1[2][2];
    const char* cA = (const char*)g.A + (size_t)cur.pm * tstep; const char* cB = (const char*)g.Bt + (size_t)cur.pn * tstep;
    PG8_STAGE(PG8_SB(0, 0), cB, voffB); PG8_STAGE(PG8_SB(0, 1), cB + hstep, voffB); PG8_STAGE(PG8_SA(0, 0), cA, voffA); PG8_STAGE(PG8_SA(0, 1), cA + hstep, voffA);
    if (wr == 1) PG8_BAR;
    PG8_WAIT_V(2); PG8_BAR;
    PG8_STAGE(PG8_SB(1, 0), cB + kstep, voffB); PG8_STAGE(PG8_SA(1, 0), cA + kstep, voffA); PG8_STAGE(PG8_SB(1, 1), cB + hstep + kstep, voffB);
    PG8_WAIT_V(6); PG8_BAR;
    for (;;) {
        const bool has_next = S.next(ui + 1, nxt);
        const bool narrow = (NARROW_PN >= 0) && (cur.pn == NARROW_PN);
        const char* nA = has_next ? (const char*)g.A + (size_t)nxt.pm * tstep : cA; const char* nB = has_next ? (const char*)g.Bt + (size_t)nxt.pn * tstep : cB;
        for (int t = 0; t < nt; t += 2) {
            const bool last = (t == nt - 2);
            const char* a1 = cA + (size_t)(t + 1) * kstep;
            const char* a2 = last ? nA : cA + (size_t)(t + 2) * kstep; const char* b2 = last ? nB : cB + (size_t)(t + 2) * kstep;
            const char* a3 = a2 + kstep; const char* b3 = b2 + kstep;
            PG8_LDB(B0, 0, 0); PG8_LDB(B1, 0, 1); PG8_SCHED; PG8_LDA(At, 0, 0); PG8_STAGE(PG8_SA(1, 1), a1 + hstep, voffA);
            PG8_WAIT_V(8); PG8_WAIT_L(0); PG8_BAR; PG8_MMA(0, 0, At, B0); if (!narrow) PG8_MMA(0, 1, At, B1); PG8_BAR; PG8_SCHED;
            PG8_LDA(At, 0, 1); PG8_STAGE(PG8_SB(0, 0), b2, voffB); PG8_STAGE(PG8_SB(0, 1), b2 + hstep, voffB); PG8_STAGE(PG8_SA(0, 0), a2, voffA);
            PG8_WAIT_V(8); PG8_WAIT_L(0); PG8_BAR; PG8_MMA(1, 0, At, B0); if (!narrow) PG8_MMA(1, 1, At, B1); PG8_BAR; PG8_SCHED;
            PG8_LDB(B0, 1, 0); PG8_LDB(B1, 1, 1); PG8_SCHED; PG8_LDA(At, 1, 0); PG8_STAGE(PG8_SA(0, 1), a2 + hstep, voffA);
            PG8_WAIT_V(8); PG8_WAIT_L(0); PG8_BAR; PG8_MMA(0, 0, At, B0); if (!narrow) PG8_MMA(0, 1, At, B1); PG8_BAR; PG8_SCHED;
            PG8_LDA(At, 1, 1); PG8_STAGE(PG8_SB(1, 0), b3, voffB); PG8_STAGE(PG8_SB(1, 1), b3 + hstep, voffB); PG8_STAGE(PG8_SA(1, 0), a3, voffA);
            PG8_WAIT_V(8); PG8_WAIT_L(0); PG8_BAR; PG8_MMA(1, 0, At, B0); if (!narrow) PG8_MMA(1, 1, At, B1); PG8_BAR; PG8_SCHED;
        }
        if (wr == 0) PG8_BAR;
        bool keep; { int fr_ = fr, fq_ = fq; asm volatile("" : "+v"(fr_), "+v"(fq_)); keep = E(acc, cur, wr, wc, fr_, fq_); }
        if (!has_next) break;
        if (!keep) {
#pragma unroll
        for (int a = 0; a < 2; ++a)
#pragma unroll
            for (int b = 0; b < 2; ++b)
#pragma unroll
                for (int m = 0; m < 4; ++m)
#pragma unroll
                    for (int n = 0; n < 2; ++n) acc[a][b][m][n] = (f32x4){0.f, 0.f, 0.f, 0.f};
        }
        cur = nxt; cA = nA; cB = nB; ++ui;
        if (wr == 1) PG8_BAR;
    }
    PG8_WAIT_V(0);
    PG8_BAR;
#undef PG8_SA
#undef PG8_SB
#undef PG8_STAGE
#undef PG8_LDA
#undef PG8_LDB
#undef PG8_MMA
#undef PG8_WAIT_V
#undef PG8_WAIT_L
#undef PG8_BAR
#undef PG8_SCHED
}
}

constexpr size_t MiB = 1u << 20;
constexpr size_t WS_CTL = 0, CTL_ZERO_BYTES = 32768;
constexpr size_t WS_WIN = 2 * MiB;
constexpr size_t WS_WAB = 12 * MiB;
constexpr size_t WS_WOUT = 14 * MiB;
constexpr size_t WS_POOL = 16 * MiB;
constexpr size_t WS_RSTD = 16 * MiB + 512 * 1024;
constexpr size_t WS_ROPEA = 17 * MiB;
constexpr size_t WS_ROPEI = 19 * MiB;
constexpr size_t WS_WI = 20 * MiB;
constexpr size_t WS_KI = 21 * MiB;
constexpr size_t WS_KB = 24 * MiB;
constexpr size_t WS_VB = 32 * MiB;
constexpr size_t WS_QI = 40 * MiB;
constexpr size_t WS_MASK = 56 * MiB;
constexpr size_t WS_QB = 72 * MiB;
constexpr size_t WS_ZA = 104 * MiB;
constexpr size_t WS_ZB = 136 * MiB;
constexpr size_t WS_UB = 168 * MiB;
constexpr size_t WS_GT = 200 * MiB;
constexpr size_t WS_XH = 328 * MiB;
constexpr size_t WS_Y = 392 * MiB;
constexpr size_t WS_END = 456 * MiB;
constexpr int CW_BAR = 4096;
static_assert((4096 + 3456) * 4 <= 32768, "control words inside the memset region");
constexpr int CW_KMAX = 2048;
constexpr int CW_Q = 3400;

constexpr int RING_BYTES = 131072;
constexpr int LDSCTL_OFF = RING_BYTES, MISC_OFF = LDSCTL_OFF + 320;
constexpr int LDS_BYTES = 163840;

#define XB_TMO      128
#define XB_XCNT(j)  (256  + 64 * (j))
#define XB_XSUB(j)  (1280 + 64 * (j))
#define XB_XGEN(j)  (2304 + 64 * (j))
#define XB_TOP      3328
#define XB_TOPGEN   3392
#define XCD_BAR_WORDS 3456
#define XB_SPIN_CAP (1u << 18)
__device__ __forceinline__ unsigned xb_ld(unsigned* p)              { return __hip_atomic_load(p, __ATOMIC_RELAXED, __HIP_MEMORY_SCOPE_AGENT); }
__device__ __forceinline__ unsigned xb_add(unsigned* p, unsigned v) { return __hip_atomic_fetch_add(p, v, __ATOMIC_RELAXED, __HIP_MEMORY_SCOPE_AGENT); }
__device__ __forceinline__ unsigned xb_xcc_id() { return (unsigned)__builtin_amdgcn_s_getreg((3 << 11) | 20) & 0xFu; }
#define XB_SPIN(cond, bar) do { unsigned _sp = 0; while (cond) { __builtin_amdgcn_s_sleep(1); \
    if ((++_sp & 255u) == 0u) { if (xb_ld(&(bar)[XB_TMO])) break; if (_sp > XB_SPIN_CAP) { atomicAdd(&(bar)[XB_TMO], 1u); break; } } } } while (0)
struct XcdBarrier { unsigned* bar; unsigned x; volatile LAS unsigned* st; };
__device__ __forceinline__ XcdBarrier xcd_barrier_post(unsigned* bar, volatile LAS unsigned* st) {
    XcdBarrier b; b.bar = bar; b.x = xb_xcc_id(); b.st = st;
    if (threadIdx.x == 0) (void)xb_add(&bar[XB_XCNT(b.x)], 1u);
    return b;
}
__device__ __forceinline__ void xcd_barrier_complete(unsigned* bar, unsigned x, unsigned& nloc, unsigned& nx) {
    const unsigned G = gridDim.x * gridDim.y * gridDim.z;
    unsigned sum, cnt, mine, sp = 0u;
    for (;;) {
        sum = 0u; cnt = 0u; mine = 0u;
#pragma unroll
        for (unsigned j = 0; j < 16; ++j) { const unsigned c = xb_ld(&bar[XB_XCNT(j)]); sum += c; cnt += (c > 0u) ? 1u : 0u; mine = (j == x) ? c : mine; }
        if (sum == G) break;
        __builtin_amdgcn_s_sleep(1);
        if ((++sp & 255u) == 0u) { if (xb_ld(&bar[XB_TMO])) break; if (sp > XB_SPIN_CAP) { atomicAdd(&bar[XB_TMO], 1u); break; } }
    }
    nloc = mine > 0u ? mine : 1u; nx = cnt > 0u ? cnt : 1u;
}
__device__ __forceinline__ void xcd_barrier(const XcdBarrier& b) {
    asm volatile("s_waitcnt vmcnt(0)" ::: "memory");
    __syncthreads();
    if (threadIdx.x == 0) {
        unsigned* bar = b.bar;
        __builtin_amdgcn_s_waitcnt(0);
        unsigned nloc = b.st[0], nx = b.st[1];
        if (nloc == 0u) { xcd_barrier_complete(bar, b.x, nloc, nx); b.st[0] = nloc; b.st[1] = nx; }
        const unsigned old = xb_add(&bar[XB_XSUB(b.x)], 1u);
        const unsigned gen = old / nloc;
        if (old + 1u == (gen + 1u) * nloc) {
            __builtin_amdgcn_fence(__ATOMIC_RELEASE, "agent");
            asm volatile("s_waitcnt vmcnt(0)" ::: "memory");
            const unsigned og = xb_add(&bar[XB_TOP], 1u);
            const unsigned tg = og / nx;
            if (og + 1u == (tg + 1u) * nx) xb_add(&bar[XB_TOPGEN], 1u);
            else XB_SPIN(xb_ld(&bar[XB_TOPGEN]) == tg, bar);
            __builtin_amdgcn_fence(__ATOMIC_ACQUIRE, "agent");
            xb_add(&bar[XB_XGEN(b.x)], 1u);
            asm volatile("s_waitcnt vmcnt(0)" ::: "memory");
        } else {
            XB_SPIN(xb_ld(&bar[XB_XGEN(b.x)]) == gen, bar);
            __builtin_amdgcn_fence(__ATOMIC_ACQUIRE, "agent");
            asm volatile("s_waitcnt vmcnt(0)" ::: "memory");
        }
    }
    __syncthreads();
}

struct Frame {
    LAS unsigned char* lds;
    int tid, lane, wave, vcu, G;
    const float *x, *norm_g, *w_in, *mbias, *qng, *kng, *pool_w, *pool_scale, *wba, *wbb, *wout; const int* pos;
    float* out; unsigned char* ws;
};
#define LDS_WAIT() asm volatile("s_waitcnt lgkmcnt(0)" ::: "memory")
#define LDS_ADD(p, v) __hip_atomic_fetch_add((LAS unsigned*)(p), (v), __ATOMIC_RELAXED, __HIP_MEMORY_SCOPE_WORKGROUP)
#define LDS_OR(p, v) __hip_atomic_fetch_or((LAS unsigned*)(p), (v), __ATOMIC_RELAXED, __HIP_MEMORY_SCOPE_WORKGROUP)


#define QUEUE_LOOP(F, qhead, N, u, ...) do { volatile LAS unsigned* qslot_ = (volatile LAS unsigned*)((F).lds + MISC_OFF); unsigned* qh_ = (qhead); \
    unsigned nxt_ = 0u; if ((F).tid == 0) nxt_ = __hip_atomic_fetch_add(qh_, 1u, __ATOMIC_RELAXED, __HIP_MEMORY_SCOPE_AGENT); \
    for (;;) { if ((F).tid == 0) qslot_[0] = nxt_; __syncthreads(); const int u = (int)qslot_[0]; if (u >= (N)) break; \
        if ((F).tid == 0) nxt_ = __hip_atomic_fetch_add(qh_, 1u, __ATOMIC_RELAXED, __HIP_MEMORY_SCOPE_AGENT); __VA_ARGS__; } \
    __syncthreads(); } while (0)
#define BATCH_QUEUE_LOOP(F, qbase, N, b0, bb, u, ...) do { volatile LAS unsigned* qslot_ = (volatile LAS unsigned*)((F).lds + MISC_OFF); unsigned* qb_ = (qbase); \
    int curb_ = (b0); unsigned nxt_ = 0u; if ((F).tid == 0) nxt_ = __hip_atomic_fetch_add(qb_ + 16 * curb_, 1u, __ATOMIC_RELAXED, __HIP_MEMORY_SCOPE_AGENT); \
    for (;;) { \
        if ((F).tid == 0) { \
            while (nxt_ >= (unsigned)(N)) { int best_ = -1; unsigned bh_ = (unsigned)(N); \
                for (int q_ = 0; q_ < 8; ++q_) { const unsigned h_ = __hip_atomic_load(qb_ + 16 * q_, __ATOMIC_RELAXED, __HIP_MEMORY_SCOPE_AGENT); if (h_ < bh_) { bh_ = h_; best_ = q_; } } \
                if (best_ < 0) break; curb_ = best_; nxt_ = __hip_atomic_fetch_add(qb_ + 16 * curb_, 1u, __ATOMIC_RELAXED, __HIP_MEMORY_SCOPE_AGENT); } \
            qslot_[0] = nxt_; qslot_[1] = (unsigned)curb_; } \
        __syncthreads(); const int u = (int)qslot_[0]; const int bb = (int)qslot_[1]; if (u >= (N)) break; \
        if ((F).tid == 0) nxt_ = __hip_atomic_fetch_add(qb_ + 16 * curb_, 1u, __ATOMIC_RELAXED, __HIP_MEMORY_SCOPE_AGENT); __VA_ARGS__; } \
    __syncthreads(); } while (0)
__device__ __forceinline__ int sigma64(int s) { return (s < 16) ? ((s & 3) + 4 * ((s >> 3) & 1) + 8 * ((s >> 2) & 1)) : s; }
__device__ __forceinline__ int win_src(int cp) {
    const int T = cp >> 8, c = cp & 255, bj = c >> 7, wc = (c >> 5) & 3, s5 = c & 31;
    if (T < 2) return 64 * (4 * T + wc) + sigma64(32 * bj + s5);
    if (T == 2) { if (wc < 2) return 512 + 64 * wc + sigma64(32 * bj + s5); return 640 + 64 * (wc - 2) + 32 * bj + s5; }
    if (T == 3) return 768 + 32 * (2 * wc + bj) + s5;
    if (T < 18) return 1064 + (cp - 1024);
    if (bj == 0 && wc == 0) return 1024 + s5;
    if (bj == 0 && wc == 1 && s5 < 8) return 1056 + s5;
    return -1;
}
template <int MODE>
__device__ __forceinline__ void p0_transpose_item(const float* W, int K, int N, u16* WT, const float* gain, LAS float* scr, int item, int lane) {
    const int nblk_k = K / 64, kb = item % nblk_k, nb = item / nblk_k, k0 = 64 * kb, n0 = 32 * nb;
    const int src = (MODE == 0) ? win_src(n0 + (lane & 31)) : (n0 + (lane & 31));
#pragma unroll 8
    for (int i = 0; i < 32; ++i) { const int kk = 2 * i + (lane >> 5); float v = 0.f; if (src >= 0) v = W[(size_t)(k0 + kk) * N + src]; if (MODE == 0) v *= gain[k0 + kk]; scr[kk * 33 + (lane & 31)] = v; }
    LDS_WAIT(); asm volatile("" ::: "memory");
    const int c = lane & 7;
#pragma unroll
    for (int j = 0; j < 4; ++j) { const int n = (lane >> 3) + 8 * j; const LAS float* s = scr + (8 * c) * 33 + n;
        u32x4 o; o.x = pk_f16(s[0 * 33], s[1 * 33]); o.y = pk_f16(s[2 * 33], s[3 * 33]); o.z = pk_f16(s[4 * 33], s[5 * 33]); o.w = pk_f16(s[6 * 33], s[7 * 33]);
        *(GAS u32x4*)(WT + (size_t)(n0 + n) * K + k0 + 8 * c) = o; }
    LDS_WAIT(); asm volatile("" ::: "memory");
}
__device__ __forceinline__ float wave_sum(float v) {
#pragma unroll
    for (int o = 1; o < 64; o <<= 1) v += __shfl_xor(v, o);
    return v;
}
__device__ __forceinline__ void p0_prologue(Frame& F) {
    LAS float* scr = (LAS float*)(F.lds + F.wave * 16384);
    const int gw = F.vcu * 8 + F.wave, NGW = F.G * 8;
    constexpr int I_IN = (DM / 64) * (NPAD / 32), I_A = (512 / 64) * (1024 / 32), I_O = (1024 / 64) * (1024 / 32), I_P = (128 / 64) * (128 / 32);
    constexpr int NITEMS = I_IN + 2 * I_A + I_O + 4 * I_P;
    for (int it = gw; it < NITEMS; it += NGW) {
        int r = it;
        if (r < I_IN) { p0_transpose_item<0>(F.w_in, DM, DIN, (u16*)(F.ws + WS_WIN), F.norm_g, scr, r, F.lane); continue; } r -= I_IN;
        if (r < I_A) { p0_transpose_item<1>(F.wba, 512, 1024, (u16*)(F.ws + WS_WAB), nullptr, scr, r, F.lane); continue; } r -= I_A;
        if (r < I_A) { p0_transpose_item<1>(F.wbb, 512, 1024, (u16*)(F.ws + WS_WAB) + (size_t)1024 * 512, nullptr, scr, r, F.lane); continue; } r -= I_A;
        if (r < I_O) { p0_transpose_item<1>(F.wout, 1024, 1024, (u16*)(F.ws + WS_WOUT), nullptr, scr, r, F.lane); continue; } r -= I_O;
        const int g = r / I_P; r -= g * I_P;
        p0_transpose_item<1>(F.pool_w + (size_t)g * 128 * 128, 128, 128, (u16*)(F.ws + WS_POOL) + (size_t)g * 128 * 128, nullptr, scr, r, F.lane);
    }
    float* rstd = (float*)(F.ws + WS_RSTD);
    for (int m0 = gw * 4; m0 < M; m0 += NGW * 4) {
        f32x4 v[4][4]; float s[4];
#pragma unroll
        for (int rr = 0; rr < 4; ++rr) { const GAS f32x4* xr = (const GAS f32x4*)(F.x + (size_t)(m0 + rr) * DM) + F.lane;
#pragma unroll
            for (int j = 0; j < 4; ++j) v[rr][j] = __builtin_nontemporal_load(xr + 64 * j); }
#pragma unroll
        for (int rr = 0; rr < 4; ++rr) { float a = 0.f;
#pragma unroll
            for (int j = 0; j < 4; ++j) a += (v[rr][j].x * v[rr][j].x + v[rr][j].y * v[rr][j].y) + (v[rr][j].z * v[rr][j].z + v[rr][j].w * v[rr][j].w);
            s[rr] = a;
            GAS u32x2* o8 = (GAS u32x2*)((u16*)(F.ws + WS_XH) + (size_t)(m0 + rr) * DM) + F.lane;
#pragma unroll
            for (int j = 0; j < 4; ++j) { u32x2 w; w.x = pk_f16(v[rr][j].x, v[rr][j].y); w.y = pk_f16(v[rr][j].z, v[rr][j].w); o8[64 * j] = w; } }
#pragma unroll
        for (int o = 1; o < 64; o <<= 1) {
#pragma unroll
            for (int rr = 0; rr < 4; ++rr) s[rr] += __shfl_xor(s[rr], o); }
        if (F.lane < 4) { const float sv = F.lane == 0 ? s[0] : F.lane == 1 ? s[1] : F.lane == 2 ? s[2] : s[3]; rstd[m0 + F.lane] = rsqrtf(sv * (1.0f / DM) + EPS); }
    }
    {
        float* ra = (float*)(F.ws + WS_ROPEA); float* ri = (float*)(F.ws + WS_ROPEI);
        const int gt = F.vcu * 512 + F.tid, NGT = F.G * 512;
        for (int idx = gt; idx < M * 12; idx += NGT) {
            const int m = idx / 12, i = idx - m * 12;
            const float inv = i == 0 ? 1.000000000e+00f : i == 1 ? 1.939227432e-01f : i == 2 ? 3.760603070e-02f : i == 3 ? 7.292664610e-03f : i == 4 ? 1.414213562e-03f : i == 5 ? 2.742481884e-04f : i == 6 ? 5.318295734e-05f : i == 7 ? 1.031338525e-05f
                            : i == 8 ? 1.000000000e+00f : i == 9 ? 3.760603070e-02f : i == 10 ? 1.414213562e-03f : 5.318295734e-05f;
            const float a = (float)F.pos[m] * inv; float sn, c; sincosf(a, &sn, &c);
            if (i < 8) { ra[(size_t)m * 16 + i] = c; ra[(size_t)m * 16 + 8 + i] = sn; } else { ri[(size_t)m * 8 + (i - 8)] = c; ri[(size_t)m * 8 + 4 + (i - 8)] = sn; }
        }
    }
}

struct EpiIn {
    const float * __restrict__ rstd, * __restrict__ ropeA, * __restrict__ ropeI, * __restrict__ qng, * __restrict__ kng, * __restrict__ mbias;
    u16 * __restrict__ QB, * __restrict__ KB, * __restrict__ VB, * __restrict__ QI, * __restrict__ KI, * __restrict__ ZA, * __restrict__ UB, * __restrict__ ZB, * __restrict__ GT; float* __restrict__ WI; unsigned* kmax;
    template <bool ISQ>
    __device__ __forceinline__ void qk_tile(const f32x4 (&acc)[2][2][4][2], u16* __restrict__ dst, int row0, int fq, const float (&rsv)[2][4]) const {
        const float* gn = ISQ ? qng : kng;
        float gv[2][2][4];
#pragma unroll
        for (int bj = 0; bj < 2; ++bj)
#pragma unroll
            for (int n = 0; n < 2; ++n)
#pragma unroll
                for (int r = 0; r < 4; ++r) gv[bj][n][r] = gn[sigma64(32 * bj + 8 * fq + 4 * n + r)] * (ISQ ? C2 : 1.0f);
        constexpr int pitch = ISQ ? 512 : 128;
#pragma unroll
        for (int ai = 0; ai < 2; ++ai)
#pragma unroll
            for (int m = 0; m < 4; ++m) {
                const int row = row0 + ai * 128 + m * 16; const float rs = rsv[ai][m];
                f32x4 v[2][2]; float ss = 0.f;
#pragma unroll
                for (int bj = 0; bj < 2; ++bj)
#pragma unroll
                    for (int n = 0; n < 2; ++n) { v[bj][n] = acc[ai][bj][m][n] * rs; ss += (v[bj][n].x * v[bj][n].x + v[bj][n].y * v[bj][n].y) + (v[bj][n].z * v[bj][n].z + v[bj][n].w * v[bj][n].w); }
                ss += __shfl_xor(ss, 16); ss += __shfl_xor(ss, 32);
                const float rinv = rsqrtf(ss * (1.0f / 64.0f) + EPS);
#pragma unroll
                for (int bj = 0; bj < 2; ++bj)
#pragma unroll
                    for (int n = 0; n < 2; ++n)
#pragma unroll
                        for (int r = 0; r < 4; ++r) v[bj][n][r] = v[bj][n][r] * rinv * gv[bj][n][r];
                if (fq < 2) {
                    const f32x4 cs = *(const f32x4*)(ropeA + (size_t)row * 16 + 4 * fq), sn = *(const f32x4*)(ropeA + (size_t)row * 16 + 8 + 4 * fq);
                    const f32x4 x1 = v[0][0], x2 = v[0][1];
                    v[0][0] = x1 * cs - x2 * sn; v[0][1] = x1 * sn + x2 * cs;
                }
#pragma unroll
                for (int bj = 0; bj < 2; ++bj) { u32x4 w; w.x = pk_bf16(v[bj][0].x, v[bj][0].y); w.y = pk_bf16(v[bj][0].z, v[bj][0].w); w.z = pk_bf16(v[bj][1].x, v[bj][1].y); w.w = pk_bf16(v[bj][1].z, v[bj][1].w);
                    *(u32x4*)(dst + (size_t)row * pitch + 32 * bj + 8 * fq) = w; }
            }
    }
    template <int MODE>
    __device__ __forceinline__ void act_tile(const f32x4 (&acc)[2][2][4][2], u16* __restrict__ dst, int pitch, int colt, int row0, int wc, int fq, const float (&rsv)[2][4]) const {
        const int col0 = colt + wc * 32 + 8 * fq;
        f32x4 bv[2][2];
#pragma unroll
        for (int bj = 0; bj < 2; ++bj)
#pragma unroll
            for (int n = 0; n < 2; ++n) bv[bj][n] = (MODE == 2) ? *(const f32x4*)(mbias + col0 + bj * 128 + 4 * n) : (f32x4){0.f, 0.f, 0.f, 0.f};
#pragma unroll
        for (int ai = 0; ai < 2; ++ai)
#pragma unroll
            for (int m = 0; m < 4; ++m) { const int row = row0 + ai * 128 + m * 16; const float rs = rsv[ai][m];
#pragma unroll
                for (int bj = 0; bj < 2; ++bj) { f32x4 a = acc[ai][bj][m][0] * rs + bv[bj][0], b = acc[ai][bj][m][1] * rs + bv[bj][1];
                    if (MODE == 1) {
#pragma unroll
                        for (int r = 0; r < 4; ++r) { a[r] = silu_f(a[r]); b[r] = silu_f(b[r]); } }
                    else if (MODE == 2) {
#pragma unroll
                        for (int r = 0; r < 4; ++r) { a[r] = sigm_f(a[r]); b[r] = sigm_f(b[r]); } }
                    u32x4 w; w.x = pk_f16(a.x, a.y); w.y = pk_f16(a.z, a.w); w.z = pk_f16(b.x, b.y); w.w = pk_f16(b.z, b.w);
                    *(u32x4*)(dst + (size_t)row * pitch + col0 + bj * 128) = w; } }
    }
    __device__ __forceinline__ bool operator()(f32x4 (&acc)[2][2][4][2], const pg8::Unit& u, int wr, int wc, int fr, int fq) const {
        const int T = u.pn; const int row0 = u.pm * 256 + wr * 64 + fr;
        float rsv[2][4];
#pragma unroll
        for (int ai = 0; ai < 2; ++ai)
#pragma unroll
            for (int m = 0; m < 4; ++m) rsv[ai][m] = rstd[row0 + ai * 128 + m * 16];
        if (T < 2) { qk_tile<true>(acc, QB + (size_t)(4 * T + wc) * 64, row0, fq, rsv); }
        else if (T == 2 && wc < 2) { qk_tile<false>(acc, KB + (size_t)wc * 64, row0, fq, rsv); }
        else if (T == 2) {
            u16* dst = VB + (size_t)(wc - 2) * 64;
#pragma unroll
            for (int ai = 0; ai < 2; ++ai)
#pragma unroll
                for (int m = 0; m < 4; ++m) { const int row = row0 + ai * 128 + m * 16; const float rs = rsv[ai][m];
#pragma unroll
                    for (int bj = 0; bj < 2; ++bj) { const f32x4 a = acc[ai][bj][m][0] * rs, b = acc[ai][bj][m][1] * rs; u32x4 w; w.x = pk_bf16(a.x, a.y); w.y = pk_bf16(a.z, a.w); w.z = pk_bf16(b.x, b.y); w.w = pk_bf16(b.z, b.w);
                        *(u32x4*)(dst + (size_t)row * 128 + 32 * bj + 8 * fq) = w; } }
        } else if (T == 3) {
            const float sc = 0.17677669529663687f;
#pragma unroll
            for (int ai = 0; ai < 2; ++ai)
#pragma unroll
                for (int m = 0; m < 4; ++m) { const int row = row0 + ai * 128 + m * 16; const float rs = rsv[ai][m] * sc;
                    const f32x4 cs = *(const f32x4*)(ropeI + (size_t)row * 8), sn = *(const f32x4*)(ropeI + (size_t)row * 8 + 4);
#pragma unroll
                    for (int bj = 0; bj < 2; ++bj) { f32x4 a = acc[ai][bj][m][0] * rs, b = acc[ai][bj][m][1] * rs;
                        if (fq == 0) { const f32x4 x1 = a, x2 = b; a = x1 * cs - x2 * sn; b = x1 * sn + x2 * cs; }
                        u32x4 w; w.x = pk_f16(a.x, a.y); w.y = pk_f16(a.z, a.w); w.z = pk_f16(b.x, b.y); w.w = pk_f16(b.z, b.w);
                        *(u32x4*)(QI + (size_t)row * 256 + 32 * (2 * wc + bj) + 8 * fq) = w; } }
        } else if (T < 6) { act_tile<1>(acc, ZA, 512, (T - 4) * 256, row0, wc, fq, rsv);
        } else if (T < 8) { act_tile<0>(acc, UB, 512, (T - 6) * 256, row0, wc, fq, rsv);
        } else if (T < 10) { act_tile<1>(acc, ZB, 512, (T - 8) * 256, row0, wc, fq, rsv);
        } else if (T < 18) { act_tile<2>(acc, GT, 2048, (T - 10) * 256, row0, wc, fq, rsv);
        } else {
            if (wc == 0) {
                float mx = 0.f;
#pragma unroll
                for (int ai = 0; ai < 2; ++ai)
#pragma unroll
                    for (int m = 0; m < 4; ++m) { const int row = row0 + ai * 128 + m * 16; const float rs = rsv[ai][m];
                        const f32x4 cs = *(const f32x4*)(ropeI + (size_t)row * 8), sn = *(const f32x4*)(ropeI + (size_t)row * 8 + 4);
                        f32x4 a = acc[ai][0][m][0] * rs, b = acc[ai][0][m][1] * rs;
                        float ss = (a.x * a.x + a.y * a.y) + (a.z * a.z + a.w * a.w) + (b.x * b.x + b.y * b.y) + (b.z * b.z + b.w * b.w);
                        ss += __shfl_xor(ss, 16); ss += __shfl_xor(ss, 32); mx = fmaxf(mx, ss);
                        if (fq == 0) { const f32x4 x1 = a, x2 = b; a = x1 * cs - x2 * sn; b = x1 * sn + x2 * cs; }
                        u32x4 w; w.x = pk_f16(a.x, a.y); w.y = pk_f16(a.z, a.w); w.z = pk_f16(b.x, b.y); w.w = pk_f16(b.z, b.w);
                        *(u32x4*)(KI + (size_t)row * 32 + 8 * fq) = w; }
#pragma unroll
                for (int o = 1; o < 16; o <<= 1) mx = fmaxf(mx, __shfl_xor(mx, o));
                if ((threadIdx.x & 63) == 0) __hip_atomic_fetch_max(kmax + 64 * (u.pm >> 4), __float_as_uint(mx), __ATOMIC_RELAXED, __HIP_MEMORY_SCOPE_AGENT);
            } else if (wc == 1 && fq == 0) {
                const float sc = 0.35355339059327373f;
#pragma unroll
                for (int ai = 0; ai < 2; ++ai)
#pragma unroll
                    for (int m = 0; m < 4; ++m) { const int row = row0 + ai * 128 + m * 16; const float rs = rsv[ai][m] * sc;
                        *(f32x4*)(WI + (size_t)row * 8) = acc[ai][0][m][0] * rs; *(f32x4*)(WI + (size_t)row * 8 + 4) = acc[ai][0][m][1] * rs; }
            }
        }
        return false;
    }
};

struct EpiBranch {
    const u16* __restrict__ GT; u16* __restrict__ Y;
    __device__ __forceinline__ bool operator()(f32x4 (&acc)[2][2][4][2], const pg8::Unit& u, int wr, int wc, int fr, int fq) const {
        const int part = u.pm >= 128 ? 1 : 0; const int pm = u.pm & 127, pn = u.pn & 3;
        const int row0 = pm * 256 + wr * 64 + fr, col0 = pn * 256 + wc * 32 + 8 * fq;
#pragma unroll
        for (int ai = 0; ai < 2; ++ai) {
            u32x4 gbv[4][2], gav[4][2];
#pragma unroll
            for (int m = 0; m < 4; ++m)
#pragma unroll
                for (int bj = 0; bj < 2; ++bj) { const size_t go = (size_t)(row0 + ai * 128 + m * 16) * 2048 + col0 + bj * 128;
                    gbv[m][bj] = *(const u32x4*)(GT + go + 1024); if (part == 0) gav[m][bj] = *(const u32x4*)(GT + go); }
#pragma unroll
            for (int m = 0; m < 4; ++m) { const int row = row0 + ai * 128 + m * 16;
#pragma unroll
                for (int bj = 0; bj < 2; ++bj) { const int col = col0 + bj * 128;
                    const u32x4 gb = gbv[m][bj];
                    const f32x4 b0 = {f16lo(gb.x), f16hi(gb.x), f16lo(gb.y), f16hi(gb.y)}, b1 = {f16lo(gb.z), f16hi(gb.z), f16lo(gb.w), f16hi(gb.w)};
                    if (part == 0) {
                        const u32x4 ga = gav[m][bj];
                        const f32x4 a0 = {f16lo(ga.x), f16hi(ga.x), f16lo(ga.y), f16hi(ga.y)}, a1 = {f16lo(ga.z), f16hi(ga.z), f16lo(ga.w), f16hi(ga.w)};
#pragma unroll
                        for (int r = 0; r < 4; ++r) { acc[ai][bj][m][0][r] *= a0[r] * __builtin_amdgcn_rcpf(fmaxf(b0[r], 6e-8f)); acc[ai][bj][m][1][r] *= a1[r] * __builtin_amdgcn_rcpf(fmaxf(b1[r], 6e-8f)); }
                    } else {
                        const f32x4 a = acc[ai][bj][m][0] * b0, b = acc[ai][bj][m][1] * b1;
                        u32x4 w; w.x = pk_f16(a.x, a.y); w.y = pk_f16(a.z, a.w); w.z = pk_f16(b.x, b.y); w.w = pk_f16(b.z, b.w);
                        *(u32x4*)(Y + (size_t)row * 1024 + col) = w; } } }
        }
        return part == 0;
    }
};
struct EpiOut {
    const u16* __restrict__ XH; float* __restrict__ O;
    __device__ __forceinline__ bool operator()(f32x4 (&acc)[2][2][4][2], const pg8::Unit& u, int wr, int wc, int fr, int fq) const {
        const int row0 = u.pm * 256 + wr * 64 + fr, col0 = u.pn * 256 + wc * 32 + 8 * fq;
#pragma unroll
        for (int ai = 0; ai < 2; ++ai) {
            u32x4 xv[4][2];
#pragma unroll
            for (int m = 0; m < 4; ++m)
#pragma unroll
                for (int bj = 0; bj < 2; ++bj) xv[m][bj] = *(const u32x4*)(XH + (size_t)(row0 + ai * 128 + m * 16) * 1024 + col0 + bj * 128);
#pragma unroll
            for (int m = 0; m < 4; ++m)
#pragma unroll
                for (int bj = 0; bj < 2; ++bj) { const size_t off = (size_t)(row0 + ai * 128 + m * 16) * 1024 + col0 + bj * 128; const u32x4 xw = xv[m][bj];
                    f32x4 o0 = (f32x4){f16lo(xw.x), f16hi(xw.x), f16lo(xw.y), f16hi(xw.y)} + acc[ai][bj][m][0];
                    const f32x4 o1 = (f32x4){f16lo(xw.z), f16hi(xw.z), f16lo(xw.w), f16hi(xw.w)} + acc[ai][bj][m][1];
                    *(f32x4*)(O + off) = o0; *(f32x4*)(O + off + 4) = o1; }
        }
        return false;
    }
};

constexpr int TK_ROW = 8192;
constexpr int TK_HIST8 = RING_BYTES + 1024;
static_assert(16 * TK_ROW <= RING_BYTES && TK_HIST8 + 16384 <= LDS_BYTES && MISC_OFF + 128 <= TK_HIST8, "top-k LDS map");
__device__ __forceinline__ void tk_mfma(f32x4 (&d)[9], const f16x8 kf, const f16x8 (&qf)[8], const f16x8 lhi, const f16x8 llo) {
#pragma unroll
    for (int h = 0; h < 8; ++h) d[h] = __builtin_amdgcn_mfma_f32_16x16x32_f16(kf, qf[h], (f32x4){0.f, 0.f, 0.f, 0.f}, 0, 0, 0);
    d[8] = __builtin_amdgcn_mfma_f32_16x16x32_f16(kf, lhi, (f32x4){0.f, 0.f, 0.f, 0.f}, 0, 0, 0);
    (void)llo;
}
__device__ __forceinline__ void tk_reduce(float (&sc)[4], const f32x4 (&d)[9], const float (&w2)[8]) {
    float a0 = d[8][0], a1 = d[8][1], a2 = d[8][2], a3 = d[8][3];
#pragma unroll
    for (int h = 0; h < 8; ++h) {
        a0 = __builtin_fmaf(w2[h], __builtin_fabsf(d[h][0]), a0); asm volatile("" : "+v"(a0));
        a1 = __builtin_fmaf(w2[h], __builtin_fabsf(d[h][1]), a1); asm volatile("" : "+v"(a1));
        a2 = __builtin_fmaf(w2[h], __builtin_fabsf(d[h][2]), a2); asm volatile("" : "+v"(a2));
        a3 = __builtin_fmaf(w2[h], __builtin_fabsf(d[h][3]), a3); asm volatile("" : "+v"(a3));
    }
    sc[0] = a0; sc[1] = a1; sc[2] = a2; sc[3] = a3;
}
__device__ __forceinline__ unsigned tk_key(float s, float scale, float off) { const unsigned q = (unsigned)__builtin_fmaf(s, scale, off); return q > 65535u ? 65535u : q; }
__device__ __forceinline__ void tk_find_bin(const LAS unsigned* hist, unsigned target, int lane, unsigned& bin, unsigned& above, unsigned& atbin) {
    const u32x4 c = *(const LAS u32x4*)(hist + 4 * lane);
    const unsigned s_ = (c.x + c.y) + (c.z + c.w);
    unsigned S = s_;
#pragma unroll
    for (int o = 1; o < 64; o <<= 1) { const unsigned v = __shfl_down(S, o); if (lane + o < 64) S += v; }
    const unsigned A = S - s_;
    const unsigned long long bal = __ballot(A < target && S >= target);
    const int L0 = bal ? __builtin_ctzll(bal) : 0;
    unsigned bn = 4 * lane, ab = A, at = c.x;
    { unsigned cum = A; bool f = false;
      if (cum + c.w >= target) { bn = 4 * lane + 3; ab = cum; at = c.w; f = true; } cum += c.w;
      if (!f && cum + c.z >= target) { bn = 4 * lane + 2; ab = cum; at = c.z; f = true; } cum += c.z;
      if (!f && cum + c.y >= target) { bn = 4 * lane + 1; ab = cum; at = c.y; f = true; } cum += c.y;
      if (!f) { bn = 4 * lane; ab = cum; at = c.x; } }
    bin = (unsigned)__builtin_amdgcn_readlane((int)bn, L0); above = (unsigned)__builtin_amdgcn_readlane((int)ab, L0); atbin = (unsigned)__builtin_amdgcn_readlane((int)at, L0);
}
#define TK_SCAN(X, T1v, ACC) do { _Pragma("unroll") for (int r = 0; r < NR; ++r) { unsigned d_; asm volatile("v_pk_sub_u16 %0, %2, %3 clamp\n\tv_pk_min_u16 %0, %0, %4\n\tv_pk_add_u16 %1, %1, %0" : "=&v"(d_), "+v"(ACC) : "v"(X[r]), "v"(T1v), "v"(one2)); } } while (0)
template <int NR>
__device__ __forceinline__ void tk_select2(LAS unsigned char* rowa, LAS unsigned* hista, int q, int L, int lane, unsigned* growa) {
    const int nblk = L / 64; LAS unsigned char* rowb = rowa + TK_ROW; LAS unsigned* histb = hista + 256; unsigned* growb = growa + 128;
    for (int o = 2 * L + lane * 16; o < NR * 256; o += 1024) { *(LAS u32x4*)(rowa + o) = (u32x4){0u, 0u, 0u, 0u}; *(LAS u32x4*)(rowb + o) = (u32x4){0u, 0u, 0u, 0u}; }
    *(LAS u32x4*)(hista + 4 * lane) = (u32x4){0u, 0u, 0u, 0u}; *(LAS u32x4*)(histb + 4 * lane) = (u32x4){0u, 0u, 0u, 0u};
    asm volatile("s_waitcnt lgkmcnt(0)" ::: "memory");
    unsigned xa[NR], xb[NR];
    const LAS u16* kpa = (const LAS u16*)(rowa + (((lane >> 2) ^ q) << 3) + ((lane & 3) << 1));
    const LAS u16* kpb = (const LAS u16*)(rowb + (((lane >> 2) ^ (q + 1)) << 3) + ((lane & 3) << 1));
#pragma unroll
    for (int r = 0; r < NR; ++r) { xa[r] = (unsigned)kpa[64 * (2 * r)] | ((unsigned)kpa[64 * (2 * r + 1)] << 16); xb[r] = (unsigned)kpb[64 * (2 * r)] | ((unsigned)kpb[64 * (2 * r + 1)] << 16); }
    const unsigned one2 = 0x00010001u;
#define TK_TOT(C, TOT) do { TOT = 0u; _Pragma("unroll") for (int b2 = 0; b2 < 7; ++b2) TOT += (unsigned)__builtin_popcountll(__ballot(((C) >> b2) & 1u)) << b2; } while (0)
#define TK_FULL(TRA, TRB, TOTA, TOTB) do { const unsigned T1a_ = ((TRA) - 1u) * 0x00010001u, T1b_ = ((TRB) - 1u) * 0x00010001u; unsigned acca_ = 0u, accb_ = 0u; \
        _Pragma("unroll") for (int r = 0; r < NR; ++r) { unsigned da_, db_; \
            asm volatile("v_pk_sub_u16 %0, %4, %6 clamp\n\tv_pk_sub_u16 %1, %5, %7 clamp\n\tv_pk_min_u16 %0, %0, %8\n\tv_pk_min_u16 %1, %1, %8\n\tv_pk_add_u16 %2, %2, %0\n\tv_pk_add_u16 %3, %3, %1" \
                         : "=&v"(da_), "=&v"(db_), "+v"(acca_), "+v"(accb_) : "v"(xa[r]), "v"(xb[r]), "v"(T1a_), "v"(T1b_), "v"(one2)); } \
        const unsigned ca_ = (acca_ & 0xFFFFu) + (acca_ >> 16), cb_ = (accb_ & 0xFFFFu) + (accb_ >> 16); TK_TOT(ca_, TOTA); TK_TOT(cb_, TOTB); } while (0)
    unsigned Ha, Hb, ab1a = 0u, ab1b = 0u;
    {
        const unsigned ksamp = (unsigned)((256 * 128) / L) > 0u ? (unsigned)((256 * 128) / L) : 1u;
        unsigned sa = 0u, sb = 0u;
#pragma unroll 1
        for (int bit = 15; bit >= 8; --bit) { const unsigned tra = sa | (1u << bit), trb = sb | (1u << bit);
            const unsigned T1a_ = (tra - 1u) * 0x00010001u, T1b_ = (trb - 1u) * 0x00010001u; unsigned da_, db_;
            asm volatile("v_pk_sub_u16 %0, %2, %4 clamp\n\tv_pk_sub_u16 %1, %3, %5 clamp\n\tv_pk_min_u16 %0, %0, %6\n\tv_pk_min_u16 %1, %1, %6" : "=&v"(da_), "=&v"(db_) : "v"(xa[0]), "v"(xb[0]), "v"(T1a_), "v"(T1b_), "v"(one2));
            const unsigned ca_ = (da_ & 0xFFFFu) + (da_ >> 16), cb_ = (db_ & 0xFFFFu) + (db_ >> 16);
            const unsigned tota = (unsigned)__builtin_popcountll(__ballot(ca_ & 1u)) + 2u * (unsigned)__builtin_popcountll(__ballot(ca_ & 2u));
            const unsigned totb = (unsigned)__builtin_popcountll(__ballot(cb_ & 1u)) + 2u * (unsigned)__builtin_popcountll(__ballot(cb_ & 2u));
            if (tota >= ksamp) sa = tra; if (totb >= ksamp) sb = trb; }
        Ha = sa >> 8; Hb = sb >> 8;
        if (Ha == 0u) Ha = 1u; if (Hb == 0u) Hb = 1u;
        unsigned cloa, clob; TK_FULL(Ha << 8, Hb << 8, cloa, clob);
        bool knowa = false, knowb = false, donea = false, doneb = false;
#pragma unroll 1
        for (int guard = 0; guard < 600 && !(donea && doneb); ++guard) {
            unsigned tra, trb; int modea, modeb;
            if (donea) { modea = 0; tra = 1u; } else if (cloa < 256u) { if (Ha <= 1u) { Ha = 0u; cloa = 256u; modea = 0; tra = 1u; } else { modea = 1; tra = (Ha - 1u) << 8; } } else if (!knowa) { if (Ha >= 255u) { ab1a = 0u; knowa = true; modea = 0; tra = 1u; } else { modea = 2; tra = (Ha + 1u) << 8; } } else { modea = 0; tra = 1u; }
            if (doneb) { modeb = 0; trb = 1u; } else if (clob < 256u) { if (Hb <= 1u) { Hb = 0u; clob = 256u; modeb = 0; trb = 1u; } else { modeb = 1; trb = (Hb - 1u) << 8; } } else if (!knowb) { if (Hb >= 255u) { ab1b = 0u; knowb = true; modeb = 0; trb = 1u; } else { modeb = 2; trb = (Hb + 1u) << 8; } } else { modeb = 0; trb = 1u; }
            if (modea | modeb) { unsigned ra_, rb_; TK_FULL(tra, trb, ra_, rb_);
                if (modea == 1) { ab1a = cloa; knowa = true; cloa = ra_; --Ha; } else if (modea == 2) { if (ra_ >= 256u) { cloa = ra_; ++Ha; } else { ab1a = ra_; knowa = true; } }
                if (modeb == 1) { ab1b = clob; knowb = true; clob = rb_; --Hb; } else if (modeb == 2) { if (rb_ >= 256u) { clob = rb_; ++Hb; } else { ab1b = rb_; knowb = true; } } }
            donea = cloa >= 256u && knowa; doneb = clob >= 256u && knowb;
        }
    }
#undef TK_FULL
#undef TK_TOT
#pragma unroll
    for (int r = 0; r < NR; ++r) {
        if (((xa[r] >> 8) & 0xFFu) == Ha) LDS_ADD(hista + (xa[r] & 0xFFu), 1u); if ((xa[r] >> 24) == Ha) LDS_ADD(hista + ((xa[r] >> 16) & 0xFFu), 1u);
        if (((xb[r] >> 8) & 0xFFu) == Hb) LDS_ADD(histb + (xb[r] & 0xFFu), 1u); if ((xb[r] >> 24) == Hb) LDS_ADD(histb + ((xb[r] >> 16) & 0xFFu), 1u); }
    asm volatile("s_waitcnt lgkmcnt(0)" ::: "memory");
    unsigned Lba, ab2a, Lbb, ab2b, tiesa, tiesb; tk_find_bin(hista, 256u - ab1a, lane, Lba, ab2a, tiesa); tk_find_bin(histb, 256u - ab1b, lane, Lbb, ab2b, tiesb);
    const unsigned tfa = (Ha << 8) | Lba, tfb = (Hb << 8) | Lbb;
    unsigned needa = 256u - (ab1a + ab2a), needb = 256u - (ab1b + ab2b);
    unsigned mloa = 0u, mhia = 0u, mlob = 0u, mhib = 0u;
#define TK_BLK(X, TF, NEED, MLO, MHI) do { const unsigned key = hf ? (X[r] >> 16) : (X[r] & 0xFFFFu); \
        unsigned long long bs = __ballot(key > TF); unsigned long long bt = __ballot(key == TF); \
        if (bt) { const unsigned nt = (unsigned)__builtin_popcountll(bt); \
            if (nt <= NEED) { bs |= bt; NEED -= nt; } \
            else { while (NEED) { const int p = __builtin_ctzll(bt); bs |= 1ull << p; bt &= bt - 1ull; --NEED; } } } \
        { const unsigned blo = (unsigned)bs, bhi = (unsigned)(bs >> 32); \
          asm volatile("v_writelane_b32 %0, %2, %4\n\tv_writelane_b32 %1, %3, %4" : "+v"(MLO), "+v"(MHI) : "s"(blo), "s"(bhi), "i"(2 * r + hf)); } } while (0)
    if (tiesa == needa && tiesb == needb) {
#pragma unroll
        for (int r = 0; r < NR; ++r)
#pragma unroll
            for (int hf = 0; hf < 2; ++hf) {
                const unsigned long long ba = __ballot((hf ? (xa[r] >> 16) : (xa[r] & 0xFFFFu)) >= tfa), bb = __ballot((hf ? (xb[r] >> 16) : (xb[r] & 0xFFFFu)) >= tfb);
                const unsigned alo = (unsigned)ba, ahi = (unsigned)(ba >> 32), blo = (unsigned)bb, bhi = (unsigned)(bb >> 32);
                asm volatile("v_writelane_b32 %0, %4, %8\n\tv_writelane_b32 %1, %5, %8\n\tv_writelane_b32 %2, %6, %8\n\tv_writelane_b32 %3, %7, %8" : "+v"(mloa), "+v"(mhia), "+v"(mlob), "+v"(mhib) : "s"(alo), "s"(ahi), "s"(blo), "s"(bhi), "i"(2 * r + hf)); }
    } else {
#pragma unroll
        for (int r = 0; r < NR; ++r)
#pragma unroll
            for (int hf = 0; hf < 2; ++hf) { TK_BLK(xa, tfa, needa, mloa, mhia); TK_BLK(xb, tfb, needb, mlob, mhib); }
    }
#undef TK_BLK
    if (lane < nblk) { *(u32x2*)(growa + 2 * lane) = (u32x2){mloa, mhia}; *(u32x2*)(growb + 2 * lane) = (u32x2){mlob, mhib}; }
}
#undef TK_SCAN
__device__ __forceinline__ void topk_unit(Frame& F, int b, int qg) {
    LAS unsigned char* lds = F.lds;
    const int tid = F.tid, lane = F.lane, wave = F.wave;
    const int q0 = 16 * qg, L = 64 * ((q0 >> 6) + 1), t0 = b * SEQ + q0;
    unsigned* gmask = (unsigned*)(F.ws + WS_MASK);
    __syncthreads();
    if (L <= 256) {
#pragma unroll
        for (int rr = 0; rr < 4; ++rr) { const int q = (tid >> 7) + 4 * rr, wd = tid & 127; if (wd < L / 32) gmask[(size_t)(t0 + q) * 128 + wd] = 0xFFFFFFFFu; }
        return;
    }
    const int j = lane & 15, fq = lane >> 4;
    const u16* QI = (const u16*)(F.ws + WS_QI); const u16* KI = (const u16*)(F.ws + WS_KI); const float* WI = (const float*)(F.ws + WS_WI);
    f16x8 qf[8]; float w2[8]; f16x8 lhi, llo;
    float rsum = 0.f;
    {
        const f32x4 wa = *(const f32x4*)(WI + (size_t)(t0 + j) * 8), wb = *(const f32x4*)(WI + (size_t)(t0 + j) * 8 + 4);
        w2[0] = 0.5f * wa.x; w2[1] = 0.5f * wa.y; w2[2] = 0.5f * wa.z; w2[3] = 0.5f * wa.w; w2[4] = 0.5f * wb.x; w2[5] = 0.5f * wb.y; w2[6] = 0.5f * wb.z; w2[7] = 0.5f * wb.w;
        float lv[8];
#pragma unroll
        for (int e = 0; e < 8; ++e) lv[e] = 0.f;
#pragma unroll
        for (int h = 0; h < 8; ++h) { qf[h] = *(const f16x8*)(QI + (size_t)(t0 + j) * 256 + 32 * h + 8 * fq);
            float ss = 0.f;
#pragma unroll
            for (int e = 0; e < 8; ++e) { const float v = (float)qf[h][e]; ss += v * v; lv[e] = __builtin_fmaf(w2[h], v, lv[e]); }
            ss += __shfl_xor(ss, 16); ss += __shfl_xor(ss, 32);
            rsum += 2.0f * fabsf(w2[h]) * sqrtf(ss); }
#pragma unroll
        for (int e = 0; e < 8; ++e) { lhi[e] = (_Float16)lv[e]; llo[e] = (_Float16)(lv[e] - (float)lhi[e]); }
    }
    const float kmx = __uint_as_float(__hip_atomic_load((unsigned*)(F.ws + WS_CTL) + CW_KMAX + 64 * b, __ATOMIC_RELAXED, __HIP_MEMORY_SCOPE_AGENT));
    const float R = fmaxf(1.01f * rsum * sqrtf(kmx), 1e-30f);
    const float scale = 65534.0f / (2.0f * R), boff = R * scale;
    const int ntile = L / 16;
    const u16* kbase = KI + (size_t)(b * SEQ) * 32 + (size_t)j * 32 + 8 * fq;
    LAS unsigned char* myrow = lds + j * TK_ROW;
    {
        f16x8 cur[4], nxt[4];
#pragma unroll
        for (int u = 0; u < 4; ++u) { const int kt = wave + 8 * u; cur[u] = *(const f16x8*)(kbase + (size_t)(kt < ntile ? kt : 0) * 512); }
#pragma unroll 1
        for (int base = wave; base < ntile; base += 32) {
#pragma unroll
            for (int u = 0; u < 4; ++u) { const int kt = base + 32 + 8 * u; nxt[u] = *(const f16x8*)(kbase + (size_t)(kt < ntile ? kt : 0) * 512); }
            {
                f32x4 dA[9], dB[9]; float sc[4];
                tk_mfma(dA, cur[0], qf, lhi, llo); tk_mfma(dB, cur[1], qf, lhi, llo);
#define TK_P1(DD, U) do { tk_reduce(sc, DD, w2); const int kt = base + 8 * (U); \
                    const unsigned k0 = tk_key(sc[0], scale, boff), k1 = tk_key(sc[1], scale, boff), k2 = tk_key(sc[2], scale, boff), k3 = tk_key(sc[3], scale, boff); \
                    if (kt < ntile) *(LAS u32x2*)(myrow + (((4 * kt + fq) ^ j) << 3)) = (u32x2){k0 | (k1 << 16), k2 | (k3 << 16)}; } while (0)
                TK_P1(dA, 0); tk_mfma(dA, cur[2], qf, lhi, llo); TK_P1(dB, 1); tk_mfma(dB, cur[3], qf, lhi, llo); TK_P1(dA, 2); TK_P1(dB, 3);
#undef TK_P1
            }
#pragma unroll
            for (int u = 0; u < 4; ++u) cur[u] = nxt[u];
        }
    }
    __syncthreads();
    {
        const int q = 2 * wave; LAS unsigned char* rowb = lds + q * TK_ROW; unsigned* grow = gmask + (size_t)(t0 + q) * 128;
        int lane_ = lane; asm volatile("" : "+v"(lane_));
        LAS unsigned* hist = (LAS unsigned*)(lds + TK_HIST8 + wave * 2048);
        if (L <= 1024) tk_select2<8>(rowb, hist, q, L, lane_, grow); else if (L <= 2048) tk_select2<16>(rowb, hist, q, L, lane_, grow); else tk_select2<32>(rowb, hist, q, L, lane_, grow);
    }
}
__device__ __forceinline__ void topk_phase(Frame& F) {
    unsigned* ctl = (unsigned*)(F.ws + WS_CTL);
    const int b0 = (F.vcu * 8) / F.G;
    BATCH_QUEUE_LOOP(F, ctl + CW_Q, 256, b0, b, u, topk_unit(F, b, 255 - u));
}

constexpr int PL_U = 0, PL_P = 20480, PL_S = PL_P + 16384, PL_END = PL_S + 16384;
template <int W>
__device__ __forceinline__ void pool_item(Frame& F, int tile, int g, const f16x8 (&bfr)[8], float ps) {
    const u16* UB = (const u16*)(F.ws + WS_UB); const u16* ZB = (const u16*)(F.ws + WS_ZB); u16* ZD = (u16*)(F.ws + WS_ZB);
    LAS unsigned char* lds = F.lds;
    const int tid = F.tid, lane = F.lane, r32 = lane & 31, hi = lane >> 5, wave = F.wave, th = wave >> 2, dblk = wave & 3;
    const int t0 = tile * 64, pos0 = t0 & (SEQ - 1);
    u32x4 zpre[2];
#pragma unroll
    for (int k = 0; k < 2; ++k) { const int e = tid + 512 * k; zpre[k] = *(const u32x4*)(ZB + (size_t)(t0 + (e >> 4)) * 512 + g * 128 + (e & 15) * 8); }
#pragma unroll
    for (int k = 0; k < 2; ++k) { const int e = tid + 512 * k, t = e >> 4, ch = e & 15;
        float sum[8];
#pragma unroll
        for (int x = 0; x < 8; ++x) sum[x] = 0.f;
#pragma unroll
        for (int i = 0; i < W; ++i) { const f16x8 v = *(const LAS f16x8*)(lds + PL_U + (t + W - 1 - i) * 256 + ch * 16);
#pragma unroll
            for (int x = 0; x < 8; ++x) sum[x] += (float)v[x]; }
        const f16x8 cur = *(const LAS f16x8*)(lds + PL_U + (t + W - 1) * 256 + ch * 16);
        const int pos = pos0 + t; const float rc = 1.0f / (float)((pos + 1 < W) ? pos + 1 : W);
        f16x8 pv;
#pragma unroll
        for (int x = 0; x < 8; ++x) pv[x] = (_Float16)(sum[x] * rc - (float)cur[x]);
        *(LAS f16x8*)(lds + PL_P + t * 256 + ((ch ^ (t & 15)) * 16)) = pv; }
    __syncthreads();
    f32x16 acc = {};
#pragma unroll
    for (int ks = 0; ks < 8; ++ks) { const f16x8 afr = *(const LAS f16x8*)(lds + PL_P + (32 * th + r32) * 256 + (((2 * ks + hi) ^ (r32 & 15)) * 16));
        acc = __builtin_amdgcn_mfma_f32_32x32x16_f16(afr, bfr[ks], acc, 0, 0, 0); }
#pragma unroll
    for (int r = 0; r < 16; ++r) { const int row = 32 * th + (r & 3) + 8 * (r >> 2) + 4 * hi; *(LAS _Float16*)(lds + PL_S + row * 256 + (32 * dblk + r32) * 2) = (_Float16)(acc[r] * ps); }
    __syncthreads();
#pragma unroll
    for (int k = 0; k < 2; ++k) { const int e = tid + 512 * k, row = e >> 4, ch = e & 15;
        const u32x4 a = *(const LAS u32x4*)(lds + PL_S + row * 256 + ch * 16); const size_t off = (size_t)(t0 + row) * 512 + g * 128 + ch * 8; const u32x4 z = zpre[k];
        u32x4 w; w.x = pk_f16(f16lo(a.x) * f16lo(z.x), f16hi(a.x) * f16hi(z.x)); w.y = pk_f16(f16lo(a.y) * f16lo(z.y), f16hi(a.y) * f16hi(z.y));
        w.z = pk_f16(f16lo(a.z) * f16lo(z.z), f16hi(a.z) * f16hi(z.z)); w.w = pk_f16(f16lo(a.w) * f16lo(z.w), f16hi(a.w) * f16hi(z.w));
        *(u32x4*)(ZD + off) = w; }
}
__device__ __forceinline__ void pool_fetch(Frame& F, int tile, int g, u32x4 (&pre)[3]) {
    const u16* UB = (const u16*)(F.ws + WS_UB); const int W = 2 << g, NR = 64 + W - 1, t0 = tile * 64, pos0 = t0 & (SEQ - 1);
#pragma unroll
    for (int k = 0; k < 3; ++k) { const int idx = F.tid + 512 * k, ur = idx >> 4, ch = idx & 15; pre[k] = (u32x4){0u, 0u, 0u, 0u};
        if (idx < NR * 16 && pos0 - (W - 1) + ur >= 0) pre[k] = *(const u32x4*)(UB + (size_t)(t0 - (W - 1) + ur) * 512 + g * 128 + ch * 8); }
}
__device__ __forceinline__ void pool_phase(Frame& F) {
    const u16* PW = (const u16*)(F.ws + WS_POOL);
    const int lane = F.lane, r32 = lane & 31, hi = lane >> 5, dblk = F.wave & 3;
    int gcur = -1; f16x8 bfr[8]; float ps = 0.f;
#pragma unroll
    for (int ks = 0; ks < 8; ++ks) bfr[ks] = f16x8{};
    const int NI = (M / 64) * 4; const bool rot = (F.G & 3) == 0;
    u32x4 pre[3];
    if (F.vcu < NI) pool_fetch(F, F.vcu >> 2, rot ? (F.vcu & 3) : (F.vcu & 3), pre);
#pragma unroll 1
    for (int k = 0, item = F.vcu; item < NI; ++k, item += F.G) {
        const int tile = item >> 2, g = rot ? ((item + k) & 3) : (item & 3), W = 2 << g, NR = 64 + W - 1;
        __syncthreads();
#pragma unroll
        for (int j = 0; j < 3; ++j) { const int idx = F.tid + 512 * j; if (idx < NR * 16) *(LAS u32x4*)(F.lds + PL_U + (idx >> 4) * 256 + (idx & 15) * 16) = pre[j]; }
        if (g != gcur) { gcur = g;
#pragma unroll
            for (int ks = 0; ks < 8; ++ks) bfr[ks] = *(const f16x8*)(PW + (size_t)g * 16384 + (size_t)(32 * dblk + r32) * 128 + 16 * ks + 8 * hi);
            ps = F.pool_scale[g * 128 + 32 * dblk + r32]; }
        __syncthreads();
        { const int nitem = item + F.G; if (nitem < NI) pool_fetch(F, nitem >> 2, rot ? ((nitem + k + 1) & 3) : (nitem & 3), pre); }
        if (g == 0) pool_item<2>(F, tile, g, bfr, ps); else if (g == 1) pool_item<4>(F, tile, g, bfr, ps); else if (g == 2) pool_item<8>(F, tile, g, bfr, ps); else pool_item<16>(F, tile, g, bfr, ps);
    }
    __syncthreads();
}

namespace at2 {
typedef LAS const unsigned char* lds_cptr;
constexpr int NSLOT = 3, SLOTB = 8192;
constexpr int LDS_K = 0, LDS_V = NSLOT * SLOTB, LDS_M = 2 * NSLOT * SLOTB, LDS_WS = LDS_M + 32768, LDS_OST = LDS_WS + 2048, LDS_END = LDS_OST + 8 * 4096;
static_assert(LDS_END <= RING_BYTES, "attention LDS map");
#define SBAR() __builtin_amdgcn_sched_barrier(0)
#define WAIT_BAR(N) asm volatile("s_waitcnt vmcnt(" #N ") lgkmcnt(0)\n\ts_barrier" ::: "memory")
__device__ __forceinline__ void glds16(const void* gsrc, unsigned lds_dst) { unsigned keep;
    asm volatile("s_mov_b32 %0, m0\n\ts_mov_b32 m0, %2\n\ts_nop 0\n\tglobal_load_lds_dwordx4 %1, off\n\ts_mov_b32 m0, %0" : "=&s"(keep) : "v"(gsrc), "s"(lds_dst) : "memory"); }
__device__ __forceinline__ void kload8(s16x8* kf, lds_cptr kp) {
    kf[0] = *(const LAS s16x8*)(kp);        kf[1] = *(const LAS s16x8*)(kp + 512);
    kf[2] = *(const LAS s16x8*)(kp + 2048); kf[3] = *(const LAS s16x8*)(kp + 2560);
    kf[4] = *(const LAS s16x8*)(kp + 4096); kf[5] = *(const LAS s16x8*)(kp + 4608);
    kf[6] = *(const LAS s16x8*)(kp + 6144); kf[7] = *(const LAS s16x8*)(kp + 6656); }
__device__ __forceinline__ void kload2(s16x8* kf, lds_cptr kp, int j) { kf[2 * j] = *(const LAS s16x8*)(kp + j * 2048); kf[2 * j + 1] = *(const LAS s16x8*)(kp + j * 2048 + 512); }
__device__ __forceinline__ s16x4 vtr(lds_cptr p) { return __builtin_bit_cast(s16x4, __builtin_amdgcn_ds_read_tr16_b64_v4i16((LAS s16x4*)p)); }
__device__ __forceinline__ float mexp(float x, unsigned w, int bp) { return __uint_as_float(__float_as_uint(__builtin_amdgcn_exp2f(x)) & (unsigned)__builtin_amdgcn_sbfe((int)w, (unsigned)bp, 1u)); }
__device__ __forceinline__ void pv_drain(f32x16* o, lds_cptr vp, s16x8 pa0, s16x8 pa1, s16x8 pa2, s16x8 pa3) {
#pragma unroll
    for (int d0 = 0; d0 < 2; ++d0) { s16x4 lo[4], hh[4];
#pragma unroll
        for (int ks = 0; ks < 4; ++ks) { lo[ks] = vtr(vp + d0 * 4096 + ks * 1024); hh[ks] = vtr(vp + d0 * 4096 + ks * 1024 + 512); }
#define PK(k) (s16x8){lo[k][0], lo[k][1], lo[k][2], lo[k][3], hh[k][0], hh[k][1], hh[k][2], hh[k][3]}
        o[d0] = __builtin_amdgcn_mfma_f32_32x32x16_bf16(pa0, PK(0), o[d0], 0, 0, 0);
        o[d0] = __builtin_amdgcn_mfma_f32_32x32x16_bf16(pa1, PK(1), o[d0], 0, 0, 0);
        o[d0] = __builtin_amdgcn_mfma_f32_32x32x16_bf16(pa2, PK(2), o[d0], 0, 0, 0);
        o[d0] = __builtin_amdgcn_mfma_f32_32x32x16_bf16(pa3, PK(3), o[d0], 0, 0, 0);
#undef PK
    }
}
__device__ __forceinline__ void attn_unit(Frame& F, int b, int g, int c) {
    const int lane = F.lane, r32 = lane & 31, hi = lane >> 5, wid = F.wave;
    const u16* QB = (const u16*)(F.ws + WS_QB); const u16* KB = (const u16*)(F.ws + WS_KB); const u16* VB = (const u16*)(F.ws + WS_VB);
    const unsigned* gmask = (const unsigned*)(F.ws + WS_MASK); u16* ZA = (u16*)(F.ws + WS_ZA); u16* ZD = ZA;
    const int head = 4 * g + (wid >> 1), qrow0 = b * SEQ + 64 * c + 32 * (wid & 1);
    const int NT = c + 1;
    lds_cptr shm = (lds_cptr)F.lds; const unsigned lds0 = (unsigned)(size_t)F.lds;
    const u16* Kh = KB + (size_t)(b * SEQ) * 128 + g * 64; const u16* Vh = VB + (size_t)(b * SEQ) * 128 + g * 64;
    const u16* ksrc = Kh + (size_t)lane * 128 + wid * 8;
    const u16* vsrc = Vh + (size_t)(16 * (wid & 3) + (lane >> 2)) * 128 + (wid >> 2) * 32 + (lane & 3) * 8;
    const unsigned kdst = lds0 + LDS_K + wid * 1024, vdst = lds0 + LDS_V + wid * 1024;
#define TC(t) (((t) < NT) ? (t) : (NT - 1))
#define DMA_K(t, slot) glds16(ksrc + (size_t)TC(t) * 64 * 128, (unsigned)__builtin_amdgcn_readfirstlane(kdst + (slot)))
#define DMA_V(t, slot) glds16(vsrc + (size_t)TC(t) * 64 * 128, (unsigned)__builtin_amdgcn_readfirstlane(vdst + (slot)))
    const lds_cptr kp0 = shm + LDS_K + hi * 1024 + r32 * 16;
    const lds_cptr vp0 = shm + LDS_V + ((lane >> 4) & 1) * 32 + (lane & 3) * 8 + (4 * hi + ((lane & 15) >> 2)) * 64;
    const lds_cptr mp0 = shm + LDS_M + (32 * (wid & 1) + r32) * 16;
    for (int ch = wid; ch < (NT + 1) / 2; ch += 8) glds16(gmask + (size_t)(b * SEQ + 64 * c + lane) * 128 + ch * 4, (unsigned)__builtin_amdgcn_readfirstlane(lds0 + LDS_M + ch * 1024));
    DMA_K(0, 0); DMA_V(0, 0); DMA_K(1, SLOTB);
    s16x8 qr[4];
#pragma unroll
    for (int d0 = 0; d0 < 4; ++d0) qr[d0] = *(const s16x8*)(QB + (size_t)(qrow0 + r32) * 512 + head * 64 + d0 * 16 + hi * 8);
    float l_reg = 0.f; f32x16 o[2]; o[0] = f32x16{}; o[1] = f32x16{};
    const f32x16 zero16 = f32x16{};
    f32x16 pA0, pA1, pB0, pB1;
    int sl_prev = 0, sl_cur = 0, sl_next = SLOTB;
#define ROT() do { sl_prev = sl_cur; sl_cur = sl_next; sl_next = (sl_next == (NSLOT - 1) * SLOTB) ? 0 : sl_next + SLOTB; } while (0)
    DMA_K(2, 2 * SLOTB);
    WAIT_BAR(3);
    {
        const lds_cptr kb = kp0;
#pragma unroll
        for (int d0 = 0; d0 < 4; ++d0) {
            const s16x8 b0 = *(const LAS s16x8*)(kb + d0 * 2048), b1 = *(const LAS s16x8*)(kb + d0 * 2048 + 512);
            if (d0 == 0) { pA0 = __builtin_amdgcn_mfma_f32_32x32x16_bf16(b0, qr[0], zero16, 0, 0, 0); pA1 = __builtin_amdgcn_mfma_f32_32x32x16_bf16(b1, qr[0], zero16, 0, 0, 0); }
            else { pA0 = __builtin_amdgcn_mfma_f32_32x32x16_bf16(b0, qr[d0], pA0, 0, 0, 0); pA1 = __builtin_amdgcn_mfma_f32_32x32x16_bf16(b1, qr[d0], pA1, 0, 0, 0); } }
        const u32x2 mw = *(const LAS u32x2*)(mp0); const unsigned w0 = mw.x >> (4 * hi), w1 = mw.y >> (4 * hi);
#pragma unroll
        for (int r = 0; r < 16; ++r) { const int bp = (r & 3) + 8 * (r >> 2); pA0[r] = mexp(pA0[r], w0, bp); pA1[r] = mexp(pA1[r], w1, bp); }
    }
    WAIT_BAR(0);
    DMA_K(3, 0); DMA_V(1, SLOTB);
    ROT();
    s16x8 kf[8];
    kload8(kf, kp0 + sl_cur);
    WAIT_BAR(2);
    s16x4 vlo[8], vhi[8]; u32x4 pw0, pw1, pw2, pw3;
#define PKW(P, B) pk_bf16(P[B], P[B + 1])
#define PAF(k) __builtin_bit_cast(s16x8, pw##k)
#define VFR(i) (s16x8){vlo[i][0], vlo[i][1], vlo[i][2], vlo[i][3], vhi[i][0], vhi[i][1], vhi[i][2], vhi[i][3]}
#define PIN(x) asm volatile("" : "+v"(x))
#define GAPA(MF, A0, A1, A2, A3, W0, W1, PW, G) do { MF; sacc += A0; sacc += A1; sacc += A2; sacc += A3; PIN(sacc); W0; W1; PIN(PW); \
        mk0[2 * (G)] = (unsigned)__builtin_amdgcn_sbfe((int)w0_, (unsigned)(((2 * (G)) & 3) + 8 * ((2 * (G)) >> 2)), 1u); mk0[2 * (G) + 1] = (unsigned)__builtin_amdgcn_sbfe((int)w0_, (unsigned)(((2 * (G) + 1) & 3) + 8 * ((2 * (G) + 1) >> 2)), 1u); PIN(mk0[2 * (G)]); PIN(mk0[2 * (G) + 1]); SBAR(); } while (0)
#define GAPB(MF, X, B, W) do { MF; X[B] = mexp(X[B], W, 2 * (B)); X[B + 1] = mexp(X[B + 1], W, 2 * (B) + 1); X[B + 2] = mexp(X[B + 2], W, 2 * (B) + 2); X[B + 3] = mexp(X[B + 3], W, 2 * (B) + 3); PIN(X); SBAR(); } while (0)
#define MEXP0(x, m) __uint_as_float(__float_as_uint(__builtin_amdgcn_exp2f(x)) & (m))
#define GAPB0(MF, X, B) do { MF; X[B] = MEXP0(X[B], mk0[B]); X[B + 1] = MEXP0(X[B + 1], mk0[B + 1]); X[B + 2] = MEXP0(X[B + 2], mk0[B + 2]); X[B + 3] = MEXP0(X[B + 3], mk0[B + 3]); PIN(X); SBAR(); } while (0)
#define VRD(i) do { vlo[i] = vtr(vp_ + (((i) >> 2) * 4096 + ((i) & 3) * 1024)); vhi[i] = vtr(vp_ + (((i) >> 2) * 4096 + ((i) & 3) * 1024 + 512)); } while (0)
#define KRD(j) do { kload2(kf, kp0 + sl_next, j); SBAR(); } while (0)
#define STEP(C0, C1, P0, P1, t) do { SBAR(); \
    const lds_cptr vp_ = vp0 + sl_prev; \
    const u32x2 mw_ = *(const LAS u32x2*)(mp0 + ((t) >> 1) * 1024 + ((t) & 1) * 8); const unsigned w0_ = mw_.x >> (4 * hi), w1_ = mw_.y >> (4 * hi); \
    unsigned mk0[16]; VRD(0); SBAR(); float sacc = (P0[0] + P0[1]); \
    GAPA(C0 = __builtin_amdgcn_mfma_f32_32x32x16_bf16(kf[0], qr[0], zero16, 0, 0, 0), P0[2], P0[3], P0[4], P0[5],     pw0[0] = PKW(P0, 0), pw0[1] = PKW(P0, 2), pw0, 0); \
    VRD(4); SBAR(); GAPA(C1 = __builtin_amdgcn_mfma_f32_32x32x16_bf16(kf[1], qr[0], zero16, 0, 0, 0), P0[6], P0[7], P0[8], P0[9],     pw0[2] = PKW(P0, 4), pw0[3] = PKW(P0, 6), pw0, 1); \
    VRD(1); SBAR(); GAPA(C0 = __builtin_amdgcn_mfma_f32_32x32x16_bf16(kf[2], qr[1], C0, 0, 0, 0),   P0[10], P0[11], P0[12], P0[13], pw1[0] = PKW(P0, 8), pw1[1] = PKW(P0, 10), pw1, 2); \
    VRD(5); SBAR(); GAPA(C1 = __builtin_amdgcn_mfma_f32_32x32x16_bf16(kf[3], qr[1], C1, 0, 0, 0),   P0[14], P0[15], P1[0], P1[1],   pw1[2] = PKW(P0, 12), pw1[3] = PKW(P0, 14), pw1, 3); \
    VRD(2); SBAR(); GAPA(C0 = __builtin_amdgcn_mfma_f32_32x32x16_bf16(kf[4], qr[2], C0, 0, 0, 0),   P1[2], P1[3], P1[4], P1[5],     pw2[0] = PKW(P1, 0), pw2[1] = PKW(P1, 2), pw2, 4); \
    VRD(6); SBAR(); GAPA(C1 = __builtin_amdgcn_mfma_f32_32x32x16_bf16(kf[5], qr[2], C1, 0, 0, 0),   P1[6], P1[7], P1[8], P1[9],     pw2[2] = PKW(P1, 4), pw2[3] = PKW(P1, 6), pw2, 5); \
    VRD(3); SBAR(); GAPA(C0 = __builtin_amdgcn_mfma_f32_32x32x16_bf16(kf[6], qr[3], C0, 0, 0, 0),   P1[10], P1[11], P1[12], P1[13], pw3[0] = PKW(P1, 8), pw3[1] = PKW(P1, 10), pw3, 6); \
    VRD(7); SBAR(); GAPA(C1 = __builtin_amdgcn_mfma_f32_32x32x16_bf16(kf[7], qr[3], C1, 0, 0, 0),   P1[14], P1[15], 0.f, 0.f,       pw3[2] = PKW(P1, 12), pw3[3] = PKW(P1, 14), pw3, 7); \
    l_reg += sacc; \
    DMA_K((t) + 3, sl_cur); DMA_V((t) + 1, sl_next); \
    SBAR(); \
    GAPB0(o[0] = __builtin_amdgcn_mfma_f32_32x32x16_bf16(PAF(0), VFR(0), o[0], 0, 0, 0), C0, 0); \
    GAPB0(o[1] = __builtin_amdgcn_mfma_f32_32x32x16_bf16(PAF(0), VFR(4), o[1], 0, 0, 0), C0, 4); \
    KRD(0); GAPB0(o[0] = __builtin_amdgcn_mfma_f32_32x32x16_bf16(PAF(1), VFR(1), o[0], 0, 0, 0), C0, 8); \
    KRD(1); GAPB0(o[1] = __builtin_amdgcn_mfma_f32_32x32x16_bf16(PAF(1), VFR(5), o[1], 0, 0, 0), C0, 12); \
    KRD(2); GAPB(o[0] = __builtin_amdgcn_mfma_f32_32x32x16_bf16(PAF(2), VFR(2), o[0], 0, 0, 0), C1, 0, w1_); \
    KRD(3); GAPB(o[1] = __builtin_amdgcn_mfma_f32_32x32x16_bf16(PAF(2), VFR(6), o[1], 0, 0, 0), C1, 4, w1_); \
    GAPB(o[0] = __builtin_amdgcn_mfma_f32_32x32x16_bf16(PAF(3), VFR(3), o[0], 0, 0, 0), C1, 8, w1_); \
    GAPB(o[1] = __builtin_amdgcn_mfma_f32_32x32x16_bf16(PAF(3), VFR(7), o[1], 0, 0, 0), C1, 12, w1_); \
    } while (0)
#define DRAIN(P0, P1) do { float sacc = 0.f; _Pragma("unroll") for (int r = 0; r < 16; ++r) sacc += P0[r] + P1[r]; l_reg += sacc; \
    pw0 = (u32x4){PKW(P0, 0), PKW(P0, 2), PKW(P0, 4), PKW(P0, 6)}; pw1 = (u32x4){PKW(P0, 8), PKW(P0, 10), PKW(P0, 12), PKW(P0, 14)}; \
    pw2 = (u32x4){PKW(P1, 0), PKW(P1, 2), PKW(P1, 4), PKW(P1, 6)}; pw3 = (u32x4){PKW(P1, 8), PKW(P1, 10), PKW(P1, 12), PKW(P1, 14)}; \
    SBAR(); pv_drain(o, vp0 + sl_prev, PAF(0), PAF(1), PAF(2), PAF(3)); } while (0)
    int t = 1;
#pragma unroll 1
    for (; t + 1 < NT; t += 2) {
        STEP(pB0, pB1, pA0, pA1, t);     WAIT_BAR(2); ROT();
        STEP(pA0, pA1, pB0, pB1, t + 1); WAIT_BAR(2); ROT();
    }
    u32x4 zpre[4];
#define ZA_PRE() do { _Pragma("unroll") for (int i = 0; i < 4; ++i) zpre[i] = *(const u32x4*)(ZA + (size_t)(qrow0 + i * 8 + (lane >> 3)) * 512 + head * 64 + (lane & 7) * 8); } while (0)
    if (t < NT) { STEP(pB0, pB1, pA0, pA1, t); WAIT_BAR(2); ROT(); ZA_PRE(); DRAIN(pB0, pB1); }
    else { ZA_PRE(); DRAIN(pA0, pA1); }
#undef ZA_PRE
    { auto rr = __builtin_amdgcn_permlane32_swap(__float_as_uint(l_reg), __float_as_uint(l_reg), false, false); l_reg = __uint_as_float(rr[0]) + __uint_as_float(rr[1]); }
    LAS float* wsf = (LAS float*)(F.lds + LDS_WS) + wid * 64;
    if (hi == 0) wsf[r32] = l_reg;
    asm volatile("s_waitcnt lgkmcnt(0)" ::: "memory");
    float rli[16];
#pragma unroll
    for (int r = 0; r < 16; ++r) rli[r] = __builtin_amdgcn_rcpf(wsf[(r & 3) + 8 * (r >> 2) + 4 * hi]);
    LAS _Float16* stg = (LAS _Float16*)(F.lds + LDS_OST) + wid * 2048;
#pragma unroll
    for (int r = 0; r < 16; ++r) { const int orow = (r & 3) + 8 * (r >> 2) + 4 * hi;
#pragma unroll
        for (int d0 = 0; d0 < 2; ++d0) stg[orow * 64 + d0 * 32 + r32] = (_Float16)(o[d0][r] * rli[r]); }
    asm volatile("s_waitcnt lgkmcnt(0)" ::: "memory");
#pragma unroll
    for (int i = 0; i < 4; ++i) { const int row = i * 8 + (lane >> 3), ch = lane & 7;
        const u32x4 a = *(const LAS u32x4*)(stg + row * 64 + ch * 8);
        const u32x4 z = zpre[i];
        u32x4 w; w.x = pk_f16(f16lo(a.x) * f16lo(z.x), f16hi(a.x) * f16hi(z.x)); w.y = pk_f16(f16lo(a.y) * f16lo(z.y), f16hi(a.y) * f16hi(z.y));
        w.z = pk_f16(f16lo(a.z) * f16lo(z.z), f16hi(a.z) * f16hi(z.z)); w.w = pk_f16(f16lo(a.w) * f16lo(z.w), f16hi(a.w) * f16hi(z.w));
        *(u32x4*)(ZD + (size_t)(qrow0 + row) * 512 + head * 64 + ch * 8) = w; }
    asm volatile("s_waitcnt vmcnt(0) lgkmcnt(0)\n\ts_barrier" ::: "memory");
#undef TC
#undef DMA_K
#undef DMA_V
#undef ROT
#undef PKW
#undef PAF
#undef VFR
#undef PIN
#undef GAPA
#undef GAPB
#undef GAPB0
#undef MEXP0
#undef VRD
#undef KRD
#undef STEP
#undef DRAIN
}
#undef SBAR
#undef WAIT_BAR
}
__device__ __forceinline__ void attn_phase(Frame& F) {
    unsigned* ctl = (unsigned*)(F.ws + WS_CTL);
    if (F.G == 256) {
        const int b = F.vcu >> 5, jj = F.vcu & 31, g = jj >> 4, s_ = jj & 15;
#pragma unroll 1
        for (int i = 0; i < 4; ++i) { const int c = (i == 0) ? 63 - s_ : (i == 1) ? 32 + s_ : (i == 2) ? 31 - s_ : s_; at2::attn_unit(F, b, g, c); }
        __syncthreads();
    } else {
        const int b0 = (F.vcu * 8) / F.G;
        BATCH_QUEUE_LOOP(F, ctl + CW_Q + 16 * 8, 128, b0, b, u, at2::attn_unit(F, b, u & 1, 63 - (u >> 1)));
    }
}

struct Args { const void* in[12]; float* out; unsigned char* ws; int ph_lo, ph_hi, li, pad; };
constexpr int N_PHASES = 6;
__global__ void __launch_bounds__(512, 2) fwd_kernel(Args args) {
    extern __shared__ __attribute__((aligned(16))) unsigned char lds_raw[];
    Frame F;
    F.lds = (LAS unsigned char*)lds_raw;
    F.tid = threadIdx.x; F.lane = F.tid & 63; F.wave = __builtin_amdgcn_readfirstlane(F.tid >> 6);
    F.G = gridDim.x; { const int bx = blockIdx.x; F.vcu = (F.G % 8 == 0) ? (bx % 8) * (F.G / 8) + bx / 8 : bx; }
    F.x = (const float*)args.in[0]; F.pos = (const int*)args.in[1]; F.norm_g = (const float*)args.in[2]; F.w_in = (const float*)args.in[3]; F.mbias = (const float*)args.in[4];
    F.qng = (const float*)args.in[5]; F.kng = (const float*)args.in[6]; F.pool_w = (const float*)args.in[7]; F.pool_scale = (const float*)args.in[8];
    F.wba = (const float*)args.in[9]; F.wbb = (const float*)args.in[10]; F.wout = (const float*)args.in[11];
    F.out = args.out; F.ws = args.ws;
    unsigned* ctl = (unsigned*)(F.ws + WS_CTL);
    volatile LAS unsigned* MISC = (volatile LAS unsigned*)(F.lds + MISC_OFF);
    for (int u = F.tid; u < (LDS_BYTES - LDSCTL_OFF) / 4; u += 512) ((LAS unsigned*)(F.lds + LDSCTL_OFF))[u] = 0u;
    __syncthreads();
    XcdBarrier bar; bar.bar = ctl + CW_BAR; bar.x = 0; bar.st = nullptr;
    if (MK_N_LAUNCHES == 1) bar = xcd_barrier_post(ctl + CW_BAR, MISC + 8);
    const int lo = args.ph_lo, hi = args.ph_hi;
#define IN(k) (lo <= (k) && (k) < hi)
#define SEAM(k) do { if (IN(k) && IN((k) + 1)) xcd_barrier(bar); } while (0)
    if (IN(0)) { p0_prologue(F); SEAM(0); }
    if (IN(1)) {
        pg8::Gemm g{(const u16*)(F.ws + WS_XH), (const u16*)(F.ws + WS_WIN), M, NPAD, DM}; pg8::InProjOrder S{F.G, (int)blockIdx.x};
        EpiIn E{(const float*)(F.ws + WS_RSTD), (const float*)(F.ws + WS_ROPEA), (const float*)(F.ws + WS_ROPEI), F.qng, F.kng, F.mbias,
                (u16*)(F.ws + WS_QB), (u16*)(F.ws + WS_KB), (u16*)(F.ws + WS_VB), (u16*)(F.ws + WS_QI), (u16*)(F.ws + WS_KI), (u16*)(F.ws + WS_ZA), (u16*)(F.ws + WS_UB), (u16*)(F.ws + WS_ZB), (u16*)(F.ws + WS_GT),
                (float*)(F.ws + WS_WI), ctl + CW_KMAX};
        pg8::gemm_phase<EpiIn, pg8::InProjOrder, 18>(F.lds, g, S, E);
        SEAM(1);
    }
    if (IN(2)) { topk_phase(F); pool_phase(F); SEAM(2); }
    if (IN(3)) { attn_phase(F); SEAM(3); }
    if (IN(4)) {
        pg8::Gemm g{(const u16*)(F.ws + WS_ZA), (const u16*)(F.ws + WS_WAB), 2 * M, 2048, 512}; pg8::PairOrder S{F.G, (int)blockIdx.x};
        EpiBranch E{(const u16*)(F.ws + WS_GT), (u16*)(F.ws + WS_Y)};
        pg8::gemm_phase<EpiBranch, pg8::PairOrder>(F.lds, g, S, E);
        SEAM(4);
    }
    if (IN(5)) {
        pg8::Gemm g{(const u16*)(F.ws + WS_Y), (const u16*)(F.ws + WS_WOUT), M, DM, DM}; pg8::StaticOrder S; S.init(M, DM, F.G, (int)blockIdx.x);
        EpiOut E{(const u16*)(F.ws + WS_XH), F.out};
        pg8::gemm_phase<EpiOut, pg8::StaticOrder>(F.lds, g, S, E);
    }
#undef IN
#undef SEAM
}

extern "C" void kernel_launch(void* const* d_in, const int* in_sizes, int n_in, void* d_out, int out_size, void* d_ws, size_t ws_size, hipStream_t stream) {
    static int grid = 0;
    if (grid == 0) {
        if (n_in != 12 || out_size != M * DM || ws_size < WS_END) { fprintf(stderr, "kernel_launch: unexpected shapes (n_in %d out %d ws %zu)\n", n_in, out_size, ws_size); grid = -1; return; }
        int dev = 0, cus = 0, per_cu = 0;
        if (hipGetDevice(&dev) != hipSuccess || hipDeviceGetAttribute(&cus, hipDeviceAttributeMultiprocessorCount, dev) != hipSuccess) { grid = -1; return; }
        if (hipFuncSetAttribute((const void*)fwd_kernel, hipFuncAttributeMaxDynamicSharedMemorySize, LDS_BYTES) != hipSuccess) { fprintf(stderr, "kernel_launch: hipFuncSetAttribute failed\n"); grid = -1; return; }
        if (hipOccupancyMaxActiveBlocksPerMultiprocessor(&per_cu, (const void*)fwd_kernel, 512, LDS_BYTES) != hipSuccess || per_cu < 1) { fprintf(stderr, "kernel_launch: occupancy query says %d\n", per_cu); (void)hipGetLastError(); grid = -1; return; }
        grid = cus;
        if (grid > 256) grid = 256;
    }
    if (grid < 0) return;
    (void)hipMemsetAsync((char*)d_ws + WS_CTL, 0, CTL_ZERO_BYTES, stream);
    Args a{};
    for (int i = 0; i < 12; ++i) a.in[i] = d_in[i];
    a.out = (float*)d_out; a.ws = (unsigned char*)d_ws;
    if (MK_N_LAUNCHES == 1) {
        a.ph_lo = 0; a.ph_hi = N_PHASES; a.li = 0;
        void* kargs[] = {&a};
        hipError_t e = hipLaunchCooperativeKernel((const void*)fwd_kernel, dim3(grid), dim3(512), kargs, LDS_BYTES, stream);
        if (e != hipSuccess) fprintf(stderr, "kernel_launch: cooperative launch failed: %s\n", hipGetErrorString(e));
    } else {
        for (int li = 0; li < N_PHASES; ++li) { a.ph_lo = li; a.ph_hi = li + 1; a.li = li; hipLaunchKernelGGL(fwd_kernel, dim3(grid), dim3(512), LDS_BYTES, stream, a); }
    }
}
```
